# Optimizing an MI355X kernel written in HIP

```python
import math
import jax, jax.numpy as jnp
from jax import lax
import numpy as np

D_MODEL = 1024
BATCH = 16
SEQ = 4096
DEPTH = 4

PLE_DIM = 256
D_FF = 2816
MIX_WIDTH = D_MODEL
SSM_WIDTH = MIX_WIDTH // 2
POOL_WIDTH = MIX_WIDTH - SSM_WIDTH
SSM_GROUP_CH = 16
SSM_GROUPS = SSM_WIDTH // SSM_GROUP_CH
SSM_STATE = 64
POOL_WINDOWS = (2, 4, 8, 16)
POOL_GROUP_CH = POOL_WIDTH // len(POOL_WINDOWS)
EPS = 1e-6
DT_MIN = 1e-3
DT_MAX = 1e-1

kernel_name = "hybrid_s5_pool_macaron_ple"


def rms_norm(x, g):
    x32 = x.astype(jnp.float32)
    y = x32 * lax.rsqrt(jnp.mean(x32 * x32, axis=-1, keepdims=True) + EPS)
    return (y * g.astype(jnp.float32)).astype(x.dtype)


def swiglu(x, wi, wo):
    gu = x @ wi
    g, u = jnp.split(gu, 2, axis=-1)
    return (jax.nn.silu(g) * u) @ wo


def _ssm_combine(e1, e2):
    a1, b1 = e1
    a2, b2 = e2
    return a1 * a2, a2 * b1 + b2


def s5_mixer(u, lam_re, lam_im, log_dt, b_re, b_im, c_re, c_im, d_skip, w_glu):
    bsz, seq, _ = u.shape
    f32 = jnp.float32
    u32 = u.astype(f32)
    ug = u32.reshape(bsz, seq, SSM_GROUPS, SSM_GROUP_CH)
    lam = lax.complex(lam_re.astype(f32), lam_im.astype(f32))
    dt = jnp.exp(log_dt.astype(f32))[:, None]
    lam_bar = jnp.exp(lam * dt)
    b = lax.complex(b_re.astype(f32), b_im.astype(f32))
    b_bar = ((lam_bar - 1.0) / lam)[..., None] * b
    bu = jnp.einsum('blgh,gph->blgp', ug.astype(jnp.complex64), b_bar)
    a = jnp.broadcast_to(lam_bar[None, None], (1, seq, SSM_GROUPS, SSM_STATE))
    _, states = lax.associative_scan(_ssm_combine, (a, bu), axis=1)
    c = lax.complex(c_re.astype(f32), c_im.astype(f32))
    y = jnp.real(jnp.einsum('blgp,ghp->blgh', states, c)).reshape(bsz, seq, SSM_WIDTH)
    y = y + d_skip.astype(f32) * u32
    y = jax.nn.gelu(y)
    y = y * jax.nn.sigmoid(y @ w_glu.astype(f32))
    return y.astype(u.dtype)


def pool_mixer(u, w_pool, scale):
    bsz, seq, _ = u.shape
    u32 = u.astype(jnp.float32)
    cs = lax.cumsum(u32, axis=1)
    count = jnp.arange(1, seq + 1, dtype=jnp.float32)[:, None]
    outs = []
    for gi, win in enumerate(POOL_WINDOWS):
        sl = slice(gi * POOL_GROUP_CH, (gi + 1) * POOL_GROUP_CH)
        cg = cs[..., sl]
        prev = jnp.pad(cg, ((0, 0), (win, 0), (0, 0)))[:, :seq]
        mean = (cg - prev) / jnp.minimum(count, float(win))
        outs.append((mean - u32[..., sl]) @ w_pool[gi].astype(jnp.float32))
    y = jnp.concatenate(outs, axis=-1) * scale.astype(jnp.float32)
    return y.astype(u.dtype)


def setup_inputs(seed: int = 0) -> dict:
    key = jax.random.key(seed)
    ks = jax.random.split(key, 32)
    f32 = jnp.float32
    nrm = lambda k, shape, s: jax.random.normal(k, shape, f32) * s
    n_idx = jnp.arange(SSM_STATE, dtype=f32)
    lam_re = -0.5 + nrm(ks[0], (DEPTH, SSM_GROUPS, SSM_STATE), 0.01)
    lam_im = math.pi * n_idx[None, None, :] + nrm(ks[1], (DEPTH, SSM_GROUPS, SSM_STATE), 0.01)
    log_dt = jax.random.uniform(ks[2], (DEPTH, SSM_GROUPS), f32, math.log(DT_MIN), math.log(DT_MAX))
    return {
        "x": nrm(ks[3], (BATCH, SEQ, D_MODEL), 1.0),
        "p": nrm(ks[4], (DEPTH, BATCH, SEQ, PLE_DIM), 1.0),
        "ffn1_norm": 1.0 + nrm(ks[5], (DEPTH, D_MODEL), 0.02),
        "ffn1_wi": nrm(ks[6], (DEPTH, D_MODEL, 2 * D_FF), D_MODEL ** -0.5),
        "ffn1_wo": nrm(ks[7], (DEPTH, D_FF, D_MODEL), D_FF ** -0.5),
        "mix_norm": 1.0 + nrm(ks[8], (DEPTH, D_MODEL), 0.02),
        "w_in": nrm(ks[9], (DEPTH, D_MODEL, MIX_WIDTH), D_MODEL ** -0.5),
        "ssm_lambda_re": lam_re,
        "ssm_lambda_im": lam_im,
        "ssm_log_dt": log_dt,
        "ssm_b_re": nrm(ks[10], (DEPTH, SSM_GROUPS, SSM_STATE, SSM_GROUP_CH), (2.0 * SSM_GROUP_CH) ** -0.5),
        "ssm_b_im": nrm(ks[11], (DEPTH, SSM_GROUPS, SSM_STATE, SSM_GROUP_CH), (2.0 * SSM_GROUP_CH) ** -0.5),
        "ssm_c_re": nrm(ks[12], (DEPTH, SSM_GROUPS, SSM_GROUP_CH, SSM_STATE), (2.0 * SSM_STATE) ** -0.5),
        "ssm_c_im": nrm(ks[13], (DEPTH, SSM_GROUPS, SSM_GROUP_CH, SSM_STATE), (2.0 * SSM_STATE) ** -0.5),
        "ssm_d": nrm(ks[14], (DEPTH, SSM_WIDTH), 1.0),
        "ssm_w_glu": nrm(ks[15], (DEPTH, SSM_WIDTH, SSM_WIDTH), SSM_WIDTH ** -0.5),
        "pool_w": nrm(ks[16], (DEPTH, len(POOL_WINDOWS), POOL_GROUP_CH, POOL_GROUP_CH), POOL_GROUP_CH ** -0.5),
        "pool_scale": 1.0 + nrm(ks[17], (DEPTH, POOL_WIDTH), 0.02),
        "w_out": nrm(ks[18], (DEPTH, MIX_WIDTH, D_MODEL), MIX_WIDTH ** -0.5),
        "ffn2_norm": 1.0 + nrm(ks[19], (DEPTH, D_MODEL), 0.02),
        "ffn2_wi": nrm(ks[20], (DEPTH, D_MODEL, 2 * D_FF), D_MODEL ** -0.5),
        "ffn2_wo": nrm(ks[21], (DEPTH, D_FF, D_MODEL), D_FF ** -0.5),
        "ple_norm": 1.0 + nrm(ks[22], (DEPTH, D_MODEL), 0.02),
        "ple_w_gate": nrm(ks[23], (DEPTH, D_MODEL, D_MODEL), D_MODEL ** -0.5),
        "ple_w_proj": nrm(ks[24], (DEPTH, PLE_DIM, D_MODEL), PLE_DIM ** -0.5),
        "final_norm": 1.0 + nrm(ks[25], (D_MODEL,), 0.02),
    }


def reference(x, p, ffn1_norm, ffn1_wi, ffn1_wo, mix_norm, w_in,
              ssm_lambda_re, ssm_lambda_im, ssm_log_dt, ssm_b_re, ssm_b_im, ssm_c_re, ssm_c_im,
              ssm_d, ssm_w_glu, pool_w, pool_scale, w_out,
              ffn2_norm, ffn2_wi, ffn2_wo, ple_norm, ple_w_gate, ple_w_proj, final_norm):
    h = x
    for i in range(DEPTH):
        h = h + 0.5 * swiglu(rms_norm(h, ffn1_norm[i]), ffn1_wi[i], ffn1_wo[i])
        z = rms_norm(h, mix_norm[i]) @ w_in[i]
        y_ssm = s5_mixer(z[..., :SSM_WIDTH], ssm_lambda_re[i], ssm_lambda_im[i], ssm_log_dt[i],
                         ssm_b_re[i], ssm_b_im[i], ssm_c_re[i], ssm_c_im[i], ssm_d[i], ssm_w_glu[i])
        y_pool = pool_mixer(z[..., SSM_WIDTH:], pool_w[i], pool_scale[i])
        h = h + jnp.concatenate([y_ssm, y_pool], axis=-1) @ w_out[i]
        h = h + 0.5 * swiglu(rms_norm(h, ffn2_norm[i]), ffn2_wi[i], ffn2_wo[i])
        gate = jax.nn.sigmoid((rms_norm(h, ple_norm[i]) @ ple_w_gate[i]).astype(jnp.float32))
        h = h + (gate * (p[i] @ ple_w_proj[i]).astype(jnp.float32)).astype(h.dtype)
    return rms_norm(h, final_norm)
```

```cpp
#include <hip/hip_runtime.h>
#include <hip/hip_cooperative_groups.h>
#include <cstdio>
namespace cg = cooperative_groups;

#define LAS __attribute__((address_space(3)))
typedef unsigned short bf16_t;
typedef short bf16x8 __attribute__((ext_vector_type(8)));
typedef float f32x4 __attribute__((ext_vector_type(4)));
typedef float f32x2 __attribute__((ext_vector_type(2)));
typedef unsigned u32x4 __attribute__((ext_vector_type(4)));
typedef unsigned u32x2 __attribute__((ext_vector_type(2)));

constexpr int TT = 65536;
constexpr int SEQ = 4096;
constexpr int DM = 1024;
constexpr int FF = 2816;
constexpr int NLAYER = 4;
constexpr int NTHREADS = 512;
constexpr int STAGE_LDS = 131072;
constexpr int RS_LDS = 24576;
constexpr int LDS_BYTES = STAGE_LDS + RS_LDS;

constexpr size_t WS_HB0 = 0;
constexpr size_t WS_HB1 = 134217728ull;
constexpr size_t WS_BIG = 268435456ull;
constexpr size_t BIG_HID = 0, BIG_Z = 0, BIG_PROJ = 0, BIG_MIX = 268435456ull, BIG_YPRE = 402653184ull, BIG_E = 469762048ull;
constexpr size_t BIG_SIZE = 486539264ull;
constexpr size_t WS_PB = WS_BIG + BIG_SIZE;
constexpr size_t WS_W = WS_PB + 33554432ull;
constexpr size_t LW = 20971520ull;
constexpr size_t W_WI1 = 0, W_WO1 = 5767168, W_WIN = 8650752, W_GLU = 9699328, W_OUT = 9961472, W_WI2 = 11010048, W_WO2 = 16777216, W_GATE = 19660800, W_PLE = 20709376;
constexpr size_t WS_SSP0 = WS_W + LW * 2 * NLAYER;
constexpr size_t WS_SSP1 = WS_SSP0 + 4194304ull;
constexpr size_t WS_SSM = WS_SSP1 + 4194304ull;
constexpr size_t SSM_LAMB = 0, SSM_LAMB1K = 16384, SSM_BFRAG = 32768, SSM_CFRAG = 32768 + 131072, SSM_LBYTES = 32768 + 131072 + 131072;
constexpr size_t WS_BAR = WS_SSM + SSM_LBYTES * NLAYER;
constexpr size_t WS_END = WS_BAR + 16384;

struct Params { const float* in[26]; float* out; unsigned char* ws; };
#define GAS __attribute__((address_space(1)))
#define GP(T_, p) ((GAS T_*)(p))

typedef __bf16 bfx2_t __attribute__((ext_vector_type(2)));
__device__ __forceinline__ unsigned cvt_pk_bf16(float lo, float hi) { const f32x2 v = {lo, hi}; return __builtin_bit_cast(unsigned, __builtin_convertvector(v, bfx2_t)); }
__device__ __forceinline__ bf16_t f2bf(float f) { unsigned u = __float_as_uint(f); u += 0x7FFFu + ((u >> 16) & 1u); return (bf16_t)(u >> 16); }
__device__ __forceinline__ float bflo(unsigned w) { return __uint_as_float(w << 16); }
__device__ __forceinline__ float bfhi(unsigned w) { return __uint_as_float(w & 0xffff0000u); }
__device__ __forceinline__ float fsigmoid(float x) { return __builtin_amdgcn_rcpf(1.0f + __builtin_amdgcn_exp2f(-1.4426950408889634f * x)); }


#define XB_TMO      128
#define XB_XCNT(j)  (256  + 64 * (j))
#define XB_XSUB(j)  (1280 + 64 * (j))
#define XB_XGEN(j)  (2304 + 64 * (j))
#define XB_TOP      3328
#define XB_TOPGEN   3392
#define XCD_BAR_WORDS 3456
#define XB_SPIN_CAP (1u << 18)
__device__ __forceinline__ unsigned xb_ld(unsigned* p)              { return __hip_atomic_load(p, __ATOMIC_RELAXED, __HIP_MEMORY_SCOPE_AGENT); }
__device__ __forceinline__ unsigned xb_add(unsigned* p, unsigned v) { return __hip_atomic_fetch_add(p, v, __ATOMIC_RELAXED, __HIP_MEMORY_SCOPE_AGENT); }
__device__ __forceinline__ unsigned xb_xcc_id() { return (unsigned)__builtin_amdgcn_s_getreg((3 << 11) | 20) & 0xFu; }
#define XB_SPIN(cond, bar) do { unsigned _sp = 0; while (cond) { __builtin_amdgcn_s_sleep(1); \
    if ((++_sp & 255u) == 0u) { if (xb_ld(&(bar)[XB_TMO])) break; if (_sp > XB_SPIN_CAP) { atomicAdd(&(bar)[XB_TMO], 1u); break; } } } } while (0)
struct XcdBarrier { unsigned* bar; unsigned x; volatile LAS unsigned* st; };
__device__ __forceinline__ XcdBarrier xcd_barrier_post(unsigned* bar, volatile LAS unsigned* st) {
    XcdBarrier b; b.bar = bar; b.x = xb_xcc_id(); b.st = st;
    if (threadIdx.x == 0) (void)xb_add(&bar[XB_XCNT(b.x)], 1u);
    return b;
}
__device__ __forceinline__ void xcd_barrier_complete(unsigned* bar, unsigned x, unsigned& nloc, unsigned& nx) {
    const unsigned G = gridDim.x * gridDim.y * gridDim.z;
    unsigned sum, cnt, mine, sp = 0u;
    for (;;) {
        sum = 0u; cnt = 0u; mine = 0u;
#pragma unroll
        for (unsigned j = 0; j < 16; ++j) { const unsigned c = xb_ld(&bar[XB_XCNT(j)]); sum += c; cnt += (c > 0u) ? 1u : 0u; mine = (j == x) ? c : mine; }
        if (sum == G) break;
        __builtin_amdgcn_s_sleep(1);
        if ((++sp & 255u) == 0u) { if (xb_ld(&bar[XB_TMO])) break; if (sp > XB_SPIN_CAP) { atomicAdd(&bar[XB_TMO], 1u); break; } }
    }
    nloc = mine > 0u ? mine : 1u; nx = cnt > 0u ? cnt : 1u;
}
__device__ __forceinline__ void xcd_barrier(const XcdBarrier& b) {
    asm volatile("s_waitcnt vmcnt(0)" ::: "memory");
    __syncthreads();
    if (threadIdx.x == 0) {
        unsigned* bar = b.bar;
        __builtin_amdgcn_s_waitcnt(0);
        unsigned nloc = b.st[0], nx = b.st[1];
        if (nloc == 0u) { xcd_barrier_complete(bar, b.x, nloc, nx); b.st[0] = nloc; b.st[1] = nx; }
        const unsigned old = xb_add(&bar[XB_XSUB(b.x)], 1u);
        const unsigned gen = old / nloc;
        if (old + 1u == (gen + 1u) * nloc) {
            __builtin_amdgcn_fence(__ATOMIC_RELEASE, "agent");
            asm volatile("s_waitcnt vmcnt(0)" ::: "memory");
            const unsigned og = xb_add(&bar[XB_TOP], 1u);
            const unsigned tg = og / nx;
            if (og + 1u == (tg + 1u) * nx) xb_add(&bar[XB_TOPGEN], 1u);
            else XB_SPIN(xb_ld(&bar[XB_TOPGEN]) == tg, bar);
            __builtin_amdgcn_fence(__ATOMIC_ACQUIRE, "agent");
            xb_add(&bar[XB_XGEN(b.x)], 1u);
            asm volatile("s_waitcnt vmcnt(0)" ::: "memory");
        } else {
            XB_SPIN(xb_ld(&bar[XB_XGEN(b.x)]) == gen, bar);
            __builtin_amdgcn_fence(__ATOMIC_ACQUIRE, "agent");
            asm volatile("s_waitcnt vmcnt(0)" ::: "memory");
        }
    }
    __syncthreads();
}

namespace pg8 {
constexpr int BM = 256, BK = 64, HALF = 128, HTB = HALF * BK * 2, NXCD = 8, WGM = 8;
__device__ __forceinline__ int lds_byte(int r, int c) { const int st = (r >> 4) * 2 + (c >> 5), rr = r & 15, cc = c & 31, ob = rr * 64 + cc * 2; return st * 1024 + (ob ^ (((ob >> 9) & 1) << 5)); }
__device__ __forceinline__ void stage_rc(int b, int& R, int& C) { const int st = b / 1024, sb = b % 1024, swz = sb ^ (((sb >> 9) & 1) << 5); R = (st >> 1) * 16 + swz / 64; C = (st & 1) * 32 + (swz % 64) / 2; }
__device__ __forceinline__ int perm32(int rho) { const int n = rho >> 4, i = rho & 15; return 8 * (i >> 2) + 4 * n + (i & 3); }
struct Unit { int pm, pn; };
struct Gemm { const bf16_t* A; const bf16_t* Bt; int M, N, K; };
struct StaticOrder {
    int nM, nN, nwg, G, c;
    __device__ void init(int M, int N, int G_, int c_) { nM = M / BM; nN = N / BM; nwg = nM * nN; G = G_; c = c_; }
    __device__ bool next(int i, Unit& u) const {
        const long L = (long)i * G + c; if (L >= nwg) return false;
        int wgid = (int)L; { const int q = nwg / NXCD, r = nwg % NXCD, xcd = wgid % NXCD, off = wgid / NXCD; wgid = (xcd < r ? xcd * (q + 1) : r * (q + 1) + (xcd - r) * q) + off; }
        const int nig = WGM * nN, gid = wgid / nig, fm = gid * WGM, gsz = (nM - fm) < WGM ? (nM - fm) : WGM;
        u.pm = fm + ((wgid % nig) % gsz); u.pn = (wgid % nig) / gsz; return true;
    }
};
struct RevOrder : StaticOrder { __device__ bool next(int i, Unit& u) const { const int nr = (nwg + G - 1) / G; if (i < 0 || i >= nr) return false; return StaticOrder::next(nr - 1 - i, u); } };
template <class Epi, class Ord>
__device__ __forceinline__ void gemm_phase(LAS unsigned char* lds, const Gemm g, const Ord& S, const Epi& E) {
    int tid = threadIdx.x; asm volatile("" : "+v"(tid));
    const int wid = __builtin_amdgcn_readfirstlane(tid >> 6), lane = tid & 63, wr = wid >> 2, wc = wid & 3, fr = lane & 15, fq = lane >> 4;
    int K = g.K; asm volatile("" : "+s"(K));
    const int nt = K / BK;
    unsigned voffA[2], voffB[2];
#pragma unroll
    for (int i = 0; i < 2; ++i) { int R, C; stage_rc(tid * 16 + i * 8192, R, C); const int Rb = (R & ~31) + perm32(R & 31);
        voffA[i] = (unsigned)(R * K + C) * 2u; voffB[i] = (unsigned)(Rb * K + C) * 2u; }
    const size_t kstep = (size_t)(BK * 2);
    const size_t hstep = (size_t)HALF * K * 2;
    const size_t tstep = 2 * hstep;
    const unsigned ldsw = (unsigned)wid * 1024u;
    const int aoff = lds_byte(wr * 64 + fr, fq * 8), boff = lds_byte(wc * 32 + fr, fq * 8);
#define PG8_SA(b, h) (((b) * 2 + (h)) * HTB)
#define PG8_SB(b, h) ((4 + (b) * 2 + (h)) * HTB)
#define PG8_STAGE(bufoff, gbase, voff) do { const char* _gb = (const char*)(gbase); asm volatile("" : "+s"(_gb)); _Pragma("unroll") for (int _i = 0; _i < 2; ++_i) { unsigned _vo = (voff)[_i]; asm volatile("" : "+v"(_vo)); \
        __builtin_amdgcn_global_load_lds((const GAS unsigned*)(_gb + _vo), (LAS unsigned*)(lds + (bufoff) + ldsw + _i * 8192), 16, 0, 0); } } while (0)
#define PG8_LDA(dst, b, h) do { _Pragma("unroll") for (int m = 0; m < 4; ++m) _Pragma("unroll") for (int k = 0; k < 2; ++k) dst[m][k] = *(const LAS bf16x8*)(lds + PG8_SA(b, h) + aoff + m * 2048 + k * 1024); } while (0)
#define PG8_LDB(dst, b, h) do { _Pragma("unroll") for (int n = 0; n < 2; ++n) _Pragma("unroll") for (int k = 0; k < 2; ++k) dst[n][k] = *(const LAS bf16x8*)(lds + PG8_SB(b, h) + boff + n * 2048 + k * 1024); } while (0)
#define PG8_MMA(ai, bj, At, Bt) do { __builtin_amdgcn_s_setprio(1); _Pragma("unroll") for (int m = 0; m < 4; ++m) _Pragma("unroll") for (int n = 0; n < 2; ++n) _Pragma("unroll") for (int k = 0; k < 2; ++k) \
        acc[ai][bj][m][n] = __builtin_amdgcn_mfma_f32_16x16x32_bf16(Bt[n][k], At[m][k], acc[ai][bj][m][n], 0, 0, 0); __builtin_amdgcn_s_setprio(0); } while (0)
#define PG8_WAIT_V(n) asm volatile("s_waitcnt vmcnt(" #n ")" ::: "memory")
#define PG8_WAIT_L(n) asm volatile("s_waitcnt lgkmcnt(" #n ")" ::: "memory")
#define PG8_BAR __builtin_amdgcn_s_barrier()
#define PG8_SCHED __builtin_amdgcn_sched_barrier(0)
    Unit cur, nxt; int ui = 0;
    if (!S.next(0, cur)) return;
    f32x4 acc[2][2][4][2];
#pragma unroll
    for (int a = 0; a < 2; ++a)
#pragma unroll
        for (int b = 0; b < 2; ++b)
#pragma unroll
            for (int m = 0; m < 4; ++m)
#pragma unroll
                for (int n = 0; n < 2; ++n) acc[a][b][m][n] = (f32x4){0.f, 0.f, 0.f, 0.f};
    bf16x8 At[4][2], B0[2][2], B1[2][2];
    const char* cA = (const char*)g.A + (size_t)cur.pm * tstep; const char* cB = (const char*)g.Bt + (size_t)cur.pn * tstep;
    PG8_STAGE(PG8_SB(0, 0), cB, voffB); PG8_STAGE(PG8_SA(0, 0), cA, voffA); PG8_STAGE(PG8_SB(0, 1), cB + hstep, voffB); PG8_STAGE(PG8_SA(0, 1), cA + hstep, voffA);
    if (wr == 1) PG8_BAR;
    PG8_WAIT_V(4); PG8_BAR;
    PG8_STAGE(PG8_SB(1, 0), cB + kstep, voffB); PG8_STAGE(PG8_SA(1, 0), cA + kstep, voffA); PG8_STAGE(PG8_SB(1, 1), cB + hstep + kstep, voffB);
    PG8_WAIT_V(6); PG8_BAR;
    for (;;) {
        const bool has_next = S.next(ui + 1, nxt);
        const char* nA = has_next ? (const char*)g.A + (size_t)nxt.pm * tstep : cA; const char* nB = has_next ? (const char*)g.Bt + (size_t)nxt.pn * tstep : cB;
#pragma nounroll
        for (int t = 0; t < nt; t += 2) {
            const bool last = (t == nt - 2);
            const char* a1 = cA + (size_t)(t + 1) * kstep;
            const char* a2 = last ? nA : cA + (size_t)(t + 2) * kstep; const char* b2 = last ? nB : cB + (size_t)(t + 2) * kstep;
            const char* a3 = a2 + kstep; const char* b3 = b2 + kstep;
            PG8_LDB(B0, 0, 0); PG8_SCHED; PG8_LDA(At, 0, 0); PG8_STAGE(PG8_SA(1, 1), a1 + hstep, voffA);
            PG8_WAIT_L(8); PG8_BAR; PG8_WAIT_L(0); PG8_MMA(0, 0, At, B0); PG8_BAR; PG8_SCHED;
            PG8_LDB(B1, 0, 1); PG8_STAGE(PG8_SB(0, 0), b2, voffB);
            PG8_BAR; PG8_WAIT_L(0); PG8_MMA(0, 1, At, B1); PG8_BAR;
            PG8_LDA(At, 0, 1); PG8_STAGE(PG8_SA(0, 0), a2, voffA);
            PG8_BAR; PG8_WAIT_L(0); PG8_MMA(1, 0, At, B0); PG8_BAR; PG8_SCHED;
            PG8_STAGE(PG8_SB(0, 1), b2 + hstep, voffB);
            PG8_WAIT_V(6); PG8_BAR; PG8_MMA(1, 1, At, B1); PG8_BAR;
            PG8_LDB(B0, 1, 0); PG8_SCHED; PG8_LDA(At, 1, 0); PG8_STAGE(PG8_SA(0, 1), a2 + hstep, voffA);
            PG8_WAIT_L(8); PG8_BAR; PG8_WAIT_L(0); PG8_MMA(0, 0, At, B0); PG8_BAR; PG8_SCHED;
            PG8_LDB(B1, 1, 1); PG8_STAGE(PG8_SB(1, 0), b3, voffB);
            PG8_BAR; PG8_WAIT_L(0); PG8_MMA(0, 1, At, B1); PG8_BAR;
            PG8_LDA(At, 1, 1); PG8_STAGE(PG8_SA(1, 0), a3, voffA);
            PG8_BAR; PG8_WAIT_L(0); PG8_MMA(1, 0, At, B0); PG8_BAR; PG8_SCHED;
            PG8_STAGE(PG8_SB(1, 1), b3 + hstep, voffB);
            PG8_WAIT_V(6); PG8_BAR; PG8_MMA(1, 1, At, B1); PG8_BAR;
        }
        E(acc, cur, ui, wr, wc, fr, fq);
        if (!has_next) break;
#pragma unroll
        for (int a = 0; a < 2; ++a)
#pragma unroll
            for (int b = 0; b < 2; ++b)
#pragma unroll
                for (int m = 0; m < 4; ++m)
#pragma unroll
                    for (int n = 0; n < 2; ++n) acc[a][b][m][n] = (f32x4){0.f, 0.f, 0.f, 0.f};
        cur = nxt; cA = nA; cB = nB; ++ui;
    }
    PG8_WAIT_V(0);
    if (wr == 0) PG8_BAR;
    PG8_BAR;
#undef PG8_SA
#undef PG8_SB
#undef PG8_STAGE
#undef PG8_LDA
#undef PG8_LDB
#undef PG8_MMA
#undef PG8_WAIT_V
#undef PG8_WAIT_L
#undef PG8_BAR
#undef PG8_SCHED
}
}
using pg8::Unit;
typedef f32x4 AccT[2][2][4][2];

struct EpiSwiGLU {
    bf16_t* O; const LAS float* rs;
    __device__ __forceinline__ void operator()(const AccT& acc, const Unit& u, int ui, int wr, int wc, int fr, int fq) const {
        const int col = u.pn * 128 + wc * 32 + 8 * fq;
#pragma unroll
        for (int ai = 0; ai < 2; ++ai)
#pragma unroll
            for (int m = 0; m < 4; ++m) {
                const int rl = ai * 128 + wr * 64 + m * 16 + fr; const float r = rs[((u.pm >> 3) & 3) * 256 + rl];
                const float nr = -1.4426950408889634f * r, r2 = r * r;
                unsigned w[4];
#pragma unroll
                for (int n = 0; n < 2; ++n)
#pragma unroll
                    for (int hlf = 0; hlf < 2; ++hlf) {
                        const f32x2 a = {acc[ai][0][m][n][2 * hlf], acc[ai][0][m][n][2 * hlf + 1]}, b = {acc[ai][1][m][n][2 * hlf], acc[ai][1][m][n][2 * hlf + 1]};
                        const f32x2 t = a * nr;
                        f32x2 d; d.x = __builtin_amdgcn_exp2f(t.x); d.y = __builtin_amdgcn_exp2f(t.y); d = d + 1.0f;
                        f32x2 q; q.x = __builtin_amdgcn_rcpf(d.x); q.y = __builtin_amdgcn_rcpf(d.y);
                        const f32x2 o = ((a * b) * r2) * q;
                        w[n * 2 + hlf] = cvt_pk_bf16(o.x, o.y);
                    }
                u32x4 wv; wv.x = w[0]; wv.y = w[1]; wv.z = w[2]; wv.w = w[3];
                *GP(u32x4, O + (size_t)(u.pm * 256 + rl) * FF + col) = wv;
            }
    }
};
template <int MODE> struct EpiH {
    const float* res; float* h; bf16_t* hb; float* ssp; float alpha; const bf16_t* proj; const LAS float* rs;
    template <int NM> __device__ __forceinline__ void round(const AccT& acc, const Unit& u, int ai, int m0, int wr, int wc, int fr, int fq) const {
        f32x4 rr[NM][2][2]; u32x4 pv[NM][2];
#pragma unroll
        for (int mm = 0; mm < NM; ++mm) {
            const int rl = ai * 128 + wr * 64 + (m0 + mm) * 16 + fr;
            const size_t off = (size_t)(u.pm * 256 + rl) * DM + u.pn * 256 + wc * 32 + 8 * fq;
#pragma unroll
            for (int bj = 0; bj < 2; ++bj) {
                rr[mm][bj][0] = *GP(const f32x4, res + off + bj * 128); rr[mm][bj][1] = *GP(const f32x4, res + off + bj * 128 + 4);
                if (MODE == 1) pv[mm][bj] = *GP(const u32x4, proj + off + bj * 128);
            }
        }
#pragma unroll
        for (int mm = 0; mm < NM; ++mm) {
            const int m = m0 + mm;
            const int rl = ai * 128 + wr * 64 + m * 16 + fr; const int row = u.pm * 256 + rl;
            const size_t off = (size_t)row * DM + u.pn * 256 + wc * 32 + 8 * fq;
            float r = 1.f; if (MODE == 1) r = rs[((u.pm >> 3) & 3) * 256 + rl];
            float ss = 0.f;
#pragma unroll
            for (int bj = 0; bj < 2; ++bj) {
                f32x4 d0, d1;
                if (MODE == 0) { d0 = acc[ai][bj][m][0] * alpha; d1 = acc[ai][bj][m][1] * alpha; }
                else {
                    const u32x4 p = pv[mm][bj];
                    const f32x4 a0 = acc[ai][bj][m][0] * r, a1 = acc[ai][bj][m][1] * r;
                    d0 = (f32x4){fsigmoid(a0[0]) * bflo(p.x), fsigmoid(a0[1]) * bfhi(p.x), fsigmoid(a0[2]) * bflo(p.y), fsigmoid(a0[3]) * bfhi(p.y)};
                    d1 = (f32x4){fsigmoid(a1[0]) * bflo(p.z), fsigmoid(a1[1]) * bfhi(p.z), fsigmoid(a1[2]) * bflo(p.w), fsigmoid(a1[3]) * bfhi(p.w)};
                }
                const f32x4 o0 = rr[mm][bj][0] + d0, o1 = rr[mm][bj][1] + d1;
                *GP(f32x4, h + off + bj * 128) = o0; *GP(f32x4, h + off + bj * 128 + 4) = o1;
                u32x4 w; w.x = cvt_pk_bf16(o0[0], o0[1]); w.y = cvt_pk_bf16(o0[2], o0[3]); w.z = cvt_pk_bf16(o1[0], o1[1]); w.w = cvt_pk_bf16(o1[2], o1[3]);
                *GP(u32x4, hb + off + bj * 128) = w;
                ss += (o0[0] * o0[0] + o0[1] * o0[1]) + (o0[2] * o0[2] + o0[3] * o0[3]) + (o1[0] * o1[0] + o1[1] * o1[1]) + (o1[2] * o1[2] + o1[3] * o1[3]);
            }
            ss += __shfl_xor(ss, 16); ss += __shfl_xor(ss, 32);
            if (fq == 0) *GP(float, ssp + (size_t)(u.pn * 4 + wc) * TT + row) = ss;
        }
        asm volatile("" ::: "memory");
    }
    __device__ __forceinline__ void operator()(const AccT& acc, const Unit& u, int ui, int wr, int wc, int fr, int fq) const {
        if (MODE == 0) { round<4>(acc, u, 0, 0, wr, wc, fr, fq); round<4>(acc, u, 1, 0, wr, wc, fr, fq); }
        else { round<2>(acc, u, 0, 0, wr, wc, fr, fq); round<2>(acc, u, 0, 2, wr, wc, fr, fq); round<2>(acc, u, 1, 0, wr, wc, fr, fq); round<2>(acc, u, 1, 2, wr, wc, fr, fq); }
    }
};
struct EpiZ {
    float* Z; const LAS float* rs;
    __device__ __forceinline__ void operator()(const AccT& acc, const Unit& u, int ui, int wr, int wc, int fr, int fq) const {
#pragma unroll
        for (int ai = 0; ai < 2; ++ai)
#pragma unroll
            for (int m = 0; m < 4; ++m) {
                const int rl = ai * 128 + wr * 64 + m * 16 + fr; const float r = rs[((u.pm >> 3) & 3) * 256 + rl];
                float* p = Z + (size_t)(u.pm * 256 + rl) * DM + u.pn * 256 + wc * 32 + 8 * fq;
#pragma unroll
                for (int bj = 0; bj < 2; ++bj) { *GP(f32x4, p + bj * 128) = acc[ai][bj][m][0] * r; *GP(f32x4, p + bj * 128 + 4) = acc[ai][bj][m][1] * r; }
            }
    }
};
struct EpiGLU {
    const bf16_t* Y; bf16_t* MIX;
    __device__ __forceinline__ void operator()(const AccT& acc, const Unit& u, int ui, int wr, int wc, int fr, int fq) const {
#pragma unroll
        for (int ai = 0; ai < 2; ++ai) {
            u32x4 yv[4][2];
#pragma unroll
            for (int m = 0; m < 4; ++m)
#pragma unroll
                for (int bj = 0; bj < 2; ++bj) yv[m][bj] = *GP(const u32x4, Y + (size_t)(u.pm * 256 + ai * 128 + wr * 64 + m * 16 + fr) * 512 + u.pn * 256 + bj * 128 + wc * 32 + 8 * fq);
#pragma unroll
            for (int m = 0; m < 4; ++m) {
                const int row = u.pm * 256 + ai * 128 + wr * 64 + m * 16 + fr;
#pragma unroll
                for (int bj = 0; bj < 2; ++bj) {
                    const int col = u.pn * 256 + bj * 128 + wc * 32 + 8 * fq;
                    const u32x4 y = yv[m][bj];
                    const f32x4 a0 = acc[ai][bj][m][0], a1 = acc[ai][bj][m][1];
                    u32x4 w;
                    w.x = cvt_pk_bf16(bflo(y.x) * fsigmoid(a0[0]), bfhi(y.x) * fsigmoid(a0[1]));
                    w.y = cvt_pk_bf16(bflo(y.y) * fsigmoid(a0[2]), bfhi(y.y) * fsigmoid(a0[3]));
                    w.z = cvt_pk_bf16(bflo(y.z) * fsigmoid(a1[0]), bfhi(y.z) * fsigmoid(a1[1]));
                    w.w = cvt_pk_bf16(bflo(y.w) * fsigmoid(a1[2]), bfhi(y.w) * fsigmoid(a1[3]));
                    *GP(u32x4, MIX + (size_t)row * DM + col) = w;
                }
            }
            asm volatile("" ::: "memory");
        }
    }
};
struct EpiProj {
    bf16_t* O;
    __device__ __forceinline__ void operator()(const AccT& acc, const Unit& u, int ui, int wr, int wc, int fr, int fq) const {
#pragma unroll
        for (int ai = 0; ai < 2; ++ai)
#pragma unroll
            for (int m = 0; m < 4; ++m) {
                const int row = u.pm * 256 + ai * 128 + wr * 64 + m * 16 + fr;
                bf16_t* p = O + (size_t)row * DM + u.pn * 256 + wc * 32 + 8 * fq;
#pragma unroll
                for (int bj = 0; bj < 2; ++bj) {
                    const f32x4 a0 = acc[ai][bj][m][0], a1 = acc[ai][bj][m][1];
                    u32x4 w; w.x = cvt_pk_bf16(a0[0], a0[1]); w.y = cvt_pk_bf16(a0[2], a0[3]); w.z = cvt_pk_bf16(a1[0], a1[1]); w.w = cvt_pk_bf16(a1[2], a1[3]);
                    *GP(u32x4, p + bj * 128) = w;
                }
            }
    }
};

__device__ __forceinline__ void build_rs(LAS float* rs, const float* ssp) {
    int tid = threadIdx.x, c = blockIdx.x; asm volatile("" : "+v"(tid), "+s"(c));
#pragma unroll
    for (int e2 = 0; e2 < 2; ++e2) {
        const int e = tid + e2 * NTHREADS, slot = e >> 8, t = e & 255;
        const int pm = 32 * (c & 7) + 8 * slot + ((c >> 3) & 7); const int row = pm * 256 + t; float sacc = 0.f;
#pragma unroll
        for (int q = 0; q < 16; ++q) sacc += *GP(const float, ssp + (size_t)q * TT + row);
        rs[slot * 256 + t] = 1.0f / sqrtf(sacc * (1.0f / 1024.0f) + 1e-6f);
    }
    __syncthreads();
}

__device__ __forceinline__ void convT_tile(const float* src, int ldsrc, const float* sc, bf16_t* dst, int dstld, int k0, int n0, int swiglu, LAS float* t) {
    const int tid = threadIdx.x;
    { const int r = tid >> 6, c4 = (tid & 63) * 4;
      int ncol = n0 + c4; if (swiglu) { const int blk = n0 >> 8; ncol = (c4 < 128) ? (128 * blk + c4) : (FF + 128 * blk + (c4 - 128)); }
      f32x4 v[8]; float sv[8];
#pragma unroll
      for (int i = 0; i < 8; ++i) { const int rr = r + 8 * i; v[i] = *(const f32x4*)(src + (size_t)(k0 + rr) * ldsrc + ncol); sv[i] = sc ? sc[k0 + rr] : 1.0f; }
#pragma unroll
      for (int i = 0; i < 8; ++i) { const int rr = r + 8 * i; t[rr * 257 + c4 + 0] = v[i][0] * sv[i]; t[rr * 257 + c4 + 1] = v[i][1] * sv[i]; t[rr * 257 + c4 + 2] = v[i][2] * sv[i]; t[rr * 257 + c4 + 3] = v[i][3] * sv[i]; } }
    __syncthreads();
    { const int nn = tid >> 1, kh = (tid & 1) * 32;
#pragma unroll
      for (int q = 0; q < 4; ++q) { float v[8];
#pragma unroll
          for (int j = 0; j < 8; ++j) v[j] = t[(kh + q * 8 + j) * 257 + nn];
          u32x4 w; w.x = cvt_pk_bf16(v[0], v[1]); w.y = cvt_pk_bf16(v[2], v[3]); w.z = cvt_pk_bf16(v[4], v[5]); w.w = cvt_pk_bf16(v[6], v[7]);
          *(u32x4*)(dst + (size_t)(n0 + nn) * dstld + k0 + kh + q * 8) = w; } }
    __syncthreads();
}
__device__ __forceinline__ void convT(const float* src, int ldsrc, const float* sc, bf16_t* dst, int dstld, int Krows, int Ncols, int swiglu, LAS float* t, int& base) {
    const int G = gridDim.x, nkt = Krows / 64, ntiles = nkt * (Ncols / 256);
    int first = ((int)blockIdx.x - (base % G) + G) % G;
    for (int idx = first; idx < ntiles; idx += G) {
        const int kt = idx % nkt, ntile = idx / nkt;
        convT_tile(src, ldsrc, sc, dst, dstld, kt * 64, ntile * 256, swiglu, t);
    }
    base += ntiles;
}
__device__ __forceinline__ void conv_poolout(const float* pw, const float* pscale, const float* wout, bf16_t* dst, LAS float* t, int& base) {
    const int G = gridDim.x, tid = threadIdx.x, ntiles = 8 * 16;
    int first = ((int)blockIdx.x - (base % G) + G) % G;
    for (int idx = first; idx < ntiles; idx += G) {
        const int k0 = (idx & 7) * 64, n0 = (idx >> 3) * 64;
        const int tn = tid & 63, tk = tid >> 6; const int kb = k0 + tk * 8; const int gi = kb >> 7, kk0 = kb & 127;
        float a[8];
#pragma unroll
        for (int i = 0; i < 8; ++i) a[i] = 0.f;
        const float* pwg = pw + (size_t)gi * 128 * 128 + (size_t)kk0 * 128;
        for (int m = 0; m < 128; ++m) {
            const float w = wout[(size_t)(512 + gi * 128 + m) * DM + n0 + tn] * pscale[gi * 128 + m];
#pragma unroll
            for (int i = 0; i < 8; ++i) a[i] += pwg[i * 128 + m] * w;
        }
#pragma unroll
        for (int i = 0; i < 8; ++i) t[(tk * 8 + i) * 65 + tn] = a[i];
        __syncthreads();
        { const int nn = tid >> 3, k8 = (tid & 7) * 8; float v[8];
#pragma unroll
          for (int j = 0; j < 8; ++j) v[j] = t[(k8 + j) * 65 + nn];
          u32x4 w; w.x = cvt_pk_bf16(v[0], v[1]); w.y = cvt_pk_bf16(v[2], v[3]); w.z = cvt_pk_bf16(v[4], v[5]); w.w = cvt_pk_bf16(v[6], v[7]);
          *(u32x4*)(dst + (size_t)(n0 + nn) * DM + 512 + k0 + k8) = w; }
        __syncthreads();
    }
    base += ntiles;
}

__device__ __forceinline__ void dsincos(double th, double& s, double& c) {
    const double k = rint(th * 0.63661977236758134308);
    const double r = (th - k * 1.57079632679489655800) - k * 6.123233995736766e-17;
    const double r2 = r * r;
    const double sp = r * (1.0 + r2 * (-1.0 / 6 + r2 * (1.0 / 120 + r2 * (-1.0 / 5040 + r2 * (1.0 / 362880 + r2 * (-1.0 / 39916800 + r2 * (1.0 / 6227020800.0)))))));
    const double cp = 1.0 + r2 * (-0.5 + r2 * (1.0 / 24 + r2 * (-1.0 / 720 + r2 * (1.0 / 40320 + r2 * (-1.0 / 3628800 + r2 * (1.0 / 479001600.0 + r2 * (-1.0 / 87178291200.0)))))));
    const int q = ((int)k) & 3;
    s = (q == 0) ? sp : (q == 1) ? cp : (q == 2) ? -sp : -cp;
    c = (q == 0) ? cp : (q == 1) ? -sp : (q == 2) ? -cp : sp;
}

__device__ void prologue(const Params& P, LAS unsigned char* lds) {
    const int tid = threadIdx.x, lane = tid & 63, wave = tid >> 6, G = gridDim.x;
    unsigned char* ws = P.ws;
    {
        const float* x = P.in[0]; bf16_t* hb = (bf16_t*)(ws + WS_HB0); float* ssp = (float*)(ws + WS_SSP0);
        for (int row = blockIdx.x * 8 + wave; row < TT; row += G * 8) {
            float ss = 0.f;
#pragma unroll
            for (int q = 0; q < 4; ++q) { const f32x4 v = *(const f32x4*)(x + (size_t)row * DM + q * 256 + lane * 4);
                ss += (v[0] * v[0] + v[1] * v[1]) + (v[2] * v[2] + v[3] * v[3]);
                u32x2 w; w.x = cvt_pk_bf16(v[0], v[1]); w.y = cvt_pk_bf16(v[2], v[3]); *(u32x2*)(hb + (size_t)row * DM + q * 256 + lane * 4) = w; }
#pragma unroll
            for (int o = 32; o >= 1; o >>= 1) ss += __shfl_xor(ss, o);
            if (lane < 16) ssp[(size_t)lane * TT + row] = (lane == 0) ? ss : 0.f;
        }
    }
    {
        LAS float* t = (LAS float*)lds; int base = 0;
        for (int l = 0; l < NLAYER; ++l) {
            bf16_t* W = (bf16_t*)(ws + WS_W) + (size_t)l * LW;
            convT(P.in[3] + (size_t)l * DM * 2 * FF, 2 * FF, P.in[2] + l * DM, W + W_WI1, DM, DM, 2 * FF, 1, t, base);
            convT(P.in[4] + (size_t)l * FF * DM, DM, nullptr, W + W_WO1, FF, FF, DM, 0, t, base);
            convT(P.in[6] + (size_t)l * DM * DM, DM, P.in[5] + l * DM, W + W_WIN, DM, DM, DM, 0, t, base);
            convT(P.in[15] + (size_t)l * 512 * 512, 512, nullptr, W + W_GLU, 512, 512, 512, 0, t, base);
            convT(P.in[18] + (size_t)l * DM * DM, DM, nullptr, W + W_OUT, DM, 512, DM, 0, t, base);
            conv_poolout(P.in[16] + (size_t)l * 4 * 128 * 128, P.in[17] + l * 512, P.in[18] + (size_t)l * DM * DM, W + W_OUT, t, base);
            convT(P.in[20] + (size_t)l * DM * 2 * FF, 2 * FF, P.in[19] + l * DM, W + W_WI2, DM, DM, 2 * FF, 1, t, base);
            convT(P.in[21] + (size_t)l * FF * DM, DM, nullptr, W + W_WO2, FF, FF, DM, 0, t, base);
            convT(P.in[23] + (size_t)l * DM * DM, DM, P.in[22] + l * DM, W + W_GATE, DM, DM, DM, 0, t, base);
            convT(P.in[24] + (size_t)l * 256 * DM, DM, nullptr, W + W_PLE, 256, 256, DM, 0, t, base);
        }
    }
    {
        const int gt = blockIdx.x * NTHREADS + tid, nthr = G * NTHREADS;
        for (int it = gt; it < NLAYER * 2048; it += nthr) {
            const int l = it >> 11, gp = it & 2047, g = gp >> 6;
            const double lr = P.in[7][it], li = P.in[8][it]; const double dt = (double)expf(P.in[9][l * 32 + g]);
            double sn, cs; dsincos(li * dt, sn, cs); const double mag = (double)expf((float)(lr * dt));
            const float ar = (float)(mag * cs), ai = (float)(mag * sn);
            unsigned char* sb = ws + WS_SSM + (size_t)l * SSM_LBYTES;
            ((float*)(sb + SSM_LAMB))[gp * 2] = ar; ((float*)(sb + SSM_LAMB))[gp * 2 + 1] = ai;
            double pr = ar, pi = ai;
#pragma unroll
            for (int s = 0; s < 10; ++s) { const double nr = pr * pr - pi * pi, ni = 2.0 * pr * pi; pr = nr; pi = ni; }
            ((float*)(sb + SSM_LAMB1K))[gp * 2] = (float)pr; ((float*)(sb + SSM_LAMB1K))[gp * 2 + 1] = (float)pi;
            const double nr = mag * cs - 1.0, ni = mag * sn, den = lr * lr + li * li;
            const double qr = (nr * lr + ni * li) / den, qi = (ni * lr - nr * li) / den;
            bf16_t* Bf = (bf16_t*)(sb + SSM_BFRAG) + (size_t)g * 8 * 64 * 4;
            const float* bre = P.in[10] + (size_t)it * 16; const float* bim = P.in[11] + (size_t)it * 16;
            const int p = gp & 63, tq = p >> 4, frr = p & 15;
#pragma unroll
            for (int hh = 0; hh < 16; ++hh) { const double br = bre[hh], bi = bim[hh]; const int ln = (hh >> 2) * 16 + frr, i = hh & 3;
                Bf[((size_t)tq * 64 + ln) * 4 + i] = f2bf((float)(qr * br - qi * bi)); Bf[((size_t)(tq + 4) * 64 + ln) * 4 + i] = f2bf((float)(qr * bi + qi * br)); }
        }
        for (int it = gt; it < NLAYER * 32 * 4 * 64 * 8; it += nthr) {
            const int i = it & 7, ln = (it >> 3) & 63, kt = (it >> 9) & 3, g = (it >> 11) & 31, l = it >> 16;
            const int hh = ln & 15, k = 32 * kt + 8 * (ln >> 4) + i, p = k >> 1;
            const size_t ci = (((size_t)l * 32 + g) * 16 + hh) * 64 + p;
            const float v = (k & 1) ? -P.in[13][ci] : P.in[12][ci];
            ((bf16_t*)(ws + WS_SSM + (size_t)l * SSM_LBYTES + SSM_CFRAG))[it & 65535] = f2bf(v);
        }
    }
}

__device__ __forceinline__ void conv_p(const Params& P, int l) {
    const float* src = P.in[1] + (size_t)l * TT * 256; bf16_t* dst = (bf16_t*)(P.ws + WS_PB);
    const size_t n8 = (size_t)TT * 256 / 8, stride = (size_t)gridDim.x * NTHREADS;
    size_t i = (size_t)blockIdx.x * NTHREADS + threadIdx.x;
    for (; i + 3 * stride < n8; i += 4 * stride) {
        f32x4 a[4], b[4];
#pragma unroll
        for (int q = 0; q < 4; ++q) { a[q] = *(const f32x4*)(src + (i + q * stride) * 8); b[q] = *(const f32x4*)(src + (i + q * stride) * 8 + 4); }
#pragma unroll
        for (int q = 0; q < 4; ++q) { u32x4 w; w.x = cvt_pk_bf16(a[q][0], a[q][1]); w.y = cvt_pk_bf16(a[q][2], a[q][3]); w.z = cvt_pk_bf16(b[q][0], b[q][1]); w.w = cvt_pk_bf16(b[q][2], b[q][3]);
            *(u32x4*)(dst + (i + q * stride) * 8) = w; }
    }
    for (; i < n8; i += stride) {
        const f32x4 a = *(const f32x4*)(src + i * 8), b = *(const f32x4*)(src + i * 8 + 4);
        u32x4 w; w.x = cvt_pk_bf16(a[0], a[1]); w.y = cvt_pk_bf16(a[2], a[3]); w.z = cvt_pk_bf16(b[0], b[1]); w.w = cvt_pk_bf16(b[2], b[3]);
        *(u32x4*)(dst + i * 8) = w;
    }
}

typedef short bf16x4 __attribute__((ext_vector_type(4)));
template <int PASS> __device__ void ssm_pass(const Params& P, int l, LAS unsigned char* lds) {
    int tid = threadIdx.x; asm volatile("" : "+v"(tid));
    const int lane = tid & 63, wave = __builtin_amdgcn_readfirstlane(tid >> 6), G = gridDim.x, fr = lane & 15, fq = lane >> 4;
    unsigned char* ws = P.ws;
    const float* z = (const float*)(ws + WS_BIG + BIG_Z); float* E = (float*)(ws + WS_BIG + BIG_E); bf16_t* ypre = (bf16_t*)(ws + WS_BIG + BIG_YPRE);
    const unsigned char* sb = ws + WS_SSM + (size_t)l * SSM_LBYTES;
    const float* lamb = (const float*)(sb + SSM_LAMB); const float* lamb1k = (const float*)(sb + SSM_LAMB1K);
    const bf16_t* Bfrag = (const bf16_t*)(sb + SSM_BFRAG); const bf16_t* Cfrag = (const bf16_t*)(sb + SSM_CFRAG); const float* dskip = P.in[14] + l * 512;
    LAS unsigned char* BU = lds + wave * 12800;
    LAS unsigned char* SI = BU + 8448;
    for (int unit = blockIdx.x; unit < 256; unit += G) {
        const int b = unit >> 4, r = (unit >> 2) & 3, g = (unit & 3) * 8 + wave;
        const size_t tok0 = (size_t)b * SEQ + r * 1024;
        const f32x2 a = *(const f32x2*)(lamb + (g * 64 + lane) * 2);
        bf16x4 bf[8];
#pragma unroll
        for (int t = 0; t < 8; ++t) bf[t] = *(const bf16x4*)(Bfrag + ((size_t)(g * 8 + t) * 64 + lane) * 4);
        float sr = 0.f, si = 0.f;
        bf16x8 cf[4]; f32x4 dd;
        if (PASS == 2) {
            const f32x2 a1k = *(const f32x2*)(lamb1k + (g * 64 + lane) * 2);
            for (int rr = 0; rr < r; ++rr) { const f32x2 e = *(const f32x2*)(E + ((size_t)((b * 32 + g) * 4 + rr) * 64 + lane) * 2);
                const float nr = a1k.x * sr - a1k.y * si + e.x, ni = a1k.x * si + a1k.y * sr + e.y; sr = nr; si = ni; }
#pragma unroll
            for (int kt = 0; kt < 4; ++kt) cf[kt] = *(const bf16x8*)(Cfrag + ((size_t)(g * 4 + kt) * 64 + lane) * 8);
            dd = *(const f32x4*)(dskip + g * 16 + 4 * fq);
        }
        f32x2 sv = {sr, si}; const f32x2 axx = {a.x, a.x}, ayn = {-a.y, a.y};
        const float* zrow = z + (tok0 + fr) * DM + g * 16 + 4 * fq;
        f32x4 ucur = *(const f32x4*)zrow;
#pragma nounroll
        for (int mt = 0; mt < 64; ++mt) {
            f32x4 unext = ucur; if (mt < 63) unext = *(const f32x4*)(zrow + (size_t)(mt + 1) * 16 * DM);
            bf16x4 af; { const unsigned w0 = cvt_pk_bf16(ucur[0], ucur[1]), w1 = cvt_pk_bf16(ucur[2], ucur[3]); af[0] = (short)(w0 & 0xffff); af[1] = (short)(w0 >> 16); af[2] = (short)(w1 & 0xffff); af[3] = (short)(w1 >> 16); }
            f32x4 d[8];
#pragma unroll
            for (int t = 0; t < 8; ++t) d[t] = __builtin_amdgcn_mfma_f32_16x16x16bf16_1k(af, bf[t], (f32x4){0.f, 0.f, 0.f, 0.f}, 0, 0, 0);
#pragma unroll
            for (int tq = 0; tq < 4; ++tq)
#pragma unroll
                for (int j = 0; j < 4; ++j) *(LAS f32x2*)(BU + (4 * fq + j) * 528 + (16 * tq + fr) * 8) = (f32x2){d[tq][j], d[tq + 4][j]};
            asm volatile("s_waitcnt lgkmcnt(0)" ::: "memory");
#pragma unroll
            for (int j = 0; j < 16; ++j) {
                const f32x2 bu = *(const LAS f32x2*)(BU + j * 528 + lane * 8);
                sv = __builtin_elementwise_fma(ayn, __builtin_shufflevector(sv, sv, 1, 0), __builtin_elementwise_fma(axx, sv, bu));
                if (PASS == 2) *(LAS unsigned*)(SI + j * 272 + lane * 4) = cvt_pk_bf16(sv.x, sv.y);
            }
            if (PASS == 2) {
                asm volatile("s_waitcnt lgkmcnt(0)" ::: "memory");
                f32x4 acc = (f32x4){0.f, 0.f, 0.f, 0.f};
#pragma unroll
                for (int kt = 0; kt < 4; ++kt) { const bf16x8 sv = *(const LAS bf16x8*)(SI + fr * 272 + (32 * kt + 8 * fq) * 2);
                    acc = __builtin_amdgcn_mfma_f32_16x16x32_bf16(cf[kt], sv, acc, 0, 0, 0); }
                const size_t tok = tok0 + 16 * mt + fr;
                float o[4];
#pragma unroll
                for (int j = 0; j < 4; ++j) { const float y = acc[j] + dd[j] * ucur[j]; o[j] = y * fsigmoid(1.5957691216057308f * (y + 0.044715f * y * y * y)); }
                u32x2 w; w.x = cvt_pk_bf16(o[0], o[1]); w.y = cvt_pk_bf16(o[2], o[3]);
                *(u32x2*)(ypre + tok * 512 + g * 16 + 4 * fq) = w;
            }
            asm volatile("" ::: "memory");
            ucur = unext;
        }
        if (PASS == 1) *(f32x2*)(E + ((size_t)((b * 32 + g) * 4 + r) * 64 + lane) * 2) = sv;
    }
}

template <int W> __device__ __forceinline__ void pool_round2(const float* zpa, bf16_t* mpa, const float* zpb, bf16_t* mpb, int t0) {
    float a[W - 1 + 16], c[W - 1 + 16];
#pragma unroll
    for (int i = 0; i < W - 1 + 16; ++i) { const int t = t0 - (W - 1) + i; a[i] = (t >= 0) ? zpa[(size_t)t * DM] : 0.f; c[i] = (t >= 0) ? zpb[(size_t)t * DM] : 0.f; }
    float sa = 0.f, sc = 0.f;
#pragma unroll
    for (int i = 0; i < W - 1; ++i) { sa += a[i]; sc += c[i]; }
#pragma unroll
    for (int j = 0; j < 16; ++j) {
        const int t = t0 + j; const float va = a[W - 1 + j], vc = c[W - 1 + j]; sa += va; sc += vc;
        const float inv = 1.0f / (float)((t + 1 < W) ? t + 1 : W);
        mpa[(size_t)t * DM] = f2bf(sa * inv - va); mpb[(size_t)t * DM] = f2bf(sc * inv - vc);
        sa -= a[j]; sc -= c[j];
    }
}
__device__ void pool_phase(const Params& P) {
    int tid = threadIdx.x; asm volatile("" : "+v"(tid));
    const int G = gridDim.x; unsigned char* ws = P.ws;
    const float* z = (const float*)(ws + WS_BIG + BIG_Z); bf16_t* mix = (bf16_t*)(ws + WS_BIG + BIG_MIX);
    const int ch = tid, gi = __builtin_amdgcn_readfirstlane(ch >> 7);
    for (int q = blockIdx.x; q < 2048; q += G) {
        const int t0 = (q & 255) * 16, b0 = (q >> 8) * 2;
        const float* zpa = z + (size_t)b0 * SEQ * DM + 512 + ch; bf16_t* mpa = mix + (size_t)b0 * SEQ * DM + 512 + ch;
        const float* zpb = zpa + (size_t)SEQ * DM; bf16_t* mpb = mpa + (size_t)SEQ * DM;
        if (gi == 0) pool_round2<2>(zpa, mpa, zpb, mpb, t0); else if (gi == 1) pool_round2<4>(zpa, mpa, zpb, mpb, t0); else if (gi == 2) pool_round2<8>(zpa, mpa, zpb, mpb, t0); else pool_round2<16>(zpa, mpa, zpb, mpb, t0);
    }
}

__device__ void final_norm(const Params& P, const float* ssp) {
    const int tid = threadIdx.x, lane = tid & 63, wave = tid >> 6, G = gridDim.x;
    float* h = P.out; const float* fn = P.in[25];
    f32x4 w[4];
#pragma unroll
    for (int q = 0; q < 4; ++q) w[q] = *(const f32x4*)(fn + q * 256 + lane * 4);
    for (int row = blockIdx.x * 8 + wave; row < TT; row += G * 8) {
        float ss = (lane < 16) ? ssp[(size_t)lane * TT + row] : 0.f;
#pragma unroll
        for (int o = 32; o >= 1; o >>= 1) ss += __shfl_xor(ss, o);
        const float r = 1.0f / sqrtf(ss * (1.0f / 1024.0f) + 1e-6f);
#pragma unroll
        for (int q = 0; q < 4; ++q) { float* p = h + (size_t)row * DM + q * 256 + lane * 4; const f32x4 v = *(const f32x4*)p; *(f32x4*)p = v * r * w[q]; }
    }
}

__global__ void __launch_bounds__(NTHREADS, 2) mega_fwd(Params P) {
    extern __shared__ __attribute__((aligned(16))) unsigned char lds_raw[];
    LAS unsigned char* lds = (LAS unsigned char*)lds_raw;
    LAS float* rs = (LAS float*)(lds + STAGE_LDS);
    cg::grid_group grid = cg::this_grid();
#ifndef PHMASK
#define PHMASK 0xFFFF
#endif
#define HBC(l) ((bf16_t*)(wsb + (((l) & 1) ? WS_HB1 : WS_HB0)))
#define HBN(l) ((bf16_t*)(wsb + (((l) & 1) ? WS_HB0 : WS_HB1)))
#define SSPC(l) ((float*)(wsb + (((l) & 1) ? WS_SSP1 : WS_SSP0)))
#define SSPN(l) ((float*)(wsb + (((l) & 1) ? WS_SSP0 : WS_SSP1)))
#define WL(l) ((const bf16_t*)(wsb + WS_W) + (size_t)(l) * LW)
#define BIGP(T_, off) ((T_*)(wsb + WS_BIG + (off)))
    volatile LAS unsigned* xbst = (volatile LAS unsigned*)(lds + LDS_BYTES - 16);
    if (threadIdx.x < 4) xbst[threadIdx.x] = 0u;
    __syncthreads();
    const XcdBarrier xbar = xcd_barrier_post((unsigned*)(P.ws + WS_BAR), xbst);
    if (PHMASK & 1) prologue(P, lds);
    grid.sync();

    for (int ph = 0; ph < NLAYER * 11; ++ph) {
        const int l = ph / 11, k = ph - l * 11;
#ifndef REPK
#define REPK -1
#define REPN 1
#endif
        for (int rep = 0; rep < ((k == REPK) ? REPN : 1); ++rep) {
        int G = gridDim.x, cid = blockIdx.x; unsigned char* wsb = P.ws; asm volatile("" : "+s"(G), "+s"(cid), "+s"(wsb));
        switch (k) {
        case 0: if (PHMASK & 2) {
            pg8::RevOrder S; S.init(TT, 2 * FF, G, cid); build_rs(rs, SSPC(l));
            pg8::Gemm g{HBC(l), WL(l) + W_WI1, TT, 2 * FF, DM}; EpiSwiGLU E{BIGP(bf16_t, BIG_HID), rs}; pg8::gemm_phase(lds, g, S, E); } break;
        case 1: if (PHMASK & 4) {
            pg8::StaticOrder S; S.init(TT, DM, G, cid);
            pg8::Gemm g{BIGP(bf16_t, BIG_HID), WL(l) + W_WO1, TT, DM, FF}; EpiH<0> E{(l == 0) ? P.in[0] : P.out, P.out, HBC(l), SSPC(l), 0.5f, nullptr, rs}; pg8::gemm_phase(lds, g, S, E); } break;
        case 2: if (PHMASK & 8) {
            pg8::RevOrder S; S.init(TT, DM, G, cid); build_rs(rs, SSPC(l));
            pg8::Gemm g{HBC(l), WL(l) + W_WIN, TT, DM, DM}; EpiZ E{BIGP(float, BIG_Z), rs}; pg8::gemm_phase(lds, g, S, E); } break;
        case 3: if (PHMASK & 16) {
            ssm_pass<1>(P, l, lds); pool_phase(P); conv_p(P, l); } break;
        case 4: if (PHMASK & 32) {
            ssm_pass<2>(P, l, lds); } break;
        case 5: if (PHMASK & 64) {
            pg8::StaticOrder S; S.init(TT, 512, G, cid);
            pg8::Gemm g{BIGP(bf16_t, BIG_YPRE), WL(l) + W_GLU, TT, 512, 512}; EpiGLU E{BIGP(bf16_t, BIG_YPRE), BIGP(bf16_t, BIG_MIX)}; pg8::gemm_phase(lds, g, S, E); } break;
        case 6: if (PHMASK & 128) {
            pg8::RevOrder S; S.init(TT, DM, G, cid);
            pg8::Gemm g{BIGP(bf16_t, BIG_MIX), WL(l) + W_OUT, TT, DM, DM}; EpiH<0> E{P.out, P.out, HBC(l), SSPC(l), 1.0f, nullptr, rs}; pg8::gemm_phase(lds, g, S, E); } break;
        case 7: if (PHMASK & 256) {
            pg8::StaticOrder S; S.init(TT, 2 * FF, G, cid); build_rs(rs, SSPC(l));
            pg8::Gemm g{HBC(l), WL(l) + W_WI2, TT, 2 * FF, DM}; EpiSwiGLU E{BIGP(bf16_t, BIG_HID), rs}; pg8::gemm_phase(lds, g, S, E); } break;
        case 8: if (PHMASK & 512) {
            pg8::RevOrder S; S.init(TT, DM, G, cid);
            pg8::Gemm g{BIGP(bf16_t, BIG_HID), WL(l) + W_WO2, TT, DM, FF}; EpiH<0> E{P.out, P.out, HBC(l), SSPC(l), 0.5f, nullptr, rs}; pg8::gemm_phase(lds, g, S, E); } break;
        case 9: if (PHMASK & 1024) {
            pg8::StaticOrder S; S.init(TT, DM, G, cid); build_rs(rs, SSPC(l));
            pg8::Gemm g{(const bf16_t*)(wsb + WS_PB), WL(l) + W_PLE, TT, DM, 256}; EpiProj E{BIGP(bf16_t, BIG_PROJ)}; pg8::gemm_phase(lds, g, S, E); } break;
        default: if (PHMASK & 1024) {
            pg8::StaticOrder S; S.init(TT, DM, G, cid);
            pg8::Gemm g{HBC(l), WL(l) + W_GATE, TT, DM, DM}; EpiH<1> E{P.out, P.out, HBN(l), SSPN(l), 1.0f, BIGP(bf16_t, BIG_PROJ), rs}; pg8::gemm_phase(lds, g, S, E); } break;
        }
        if (k != 9) xcd_barrier(xbar);
        }
    }
    if (PHMASK & 0x800) final_norm(P, (const float*)(P.ws + ((NLAYER & 1) ? WS_SSP1 : WS_SSP0)));
}

extern "C" void kernel_launch(void* const* d_in, const int* in_sizes, int n_in, void* d_out, int out_size, void* d_ws, size_t ws_size, hipStream_t stream) {
    static int grid_blocks = 0;
    if (!grid_blocks) {
        int dev = 0, cus = 0, per_cu = 0;
        hipGetDevice(&dev);
        hipDeviceGetAttribute(&cus, hipDeviceAttributeMultiprocessorCount, dev);
        if (hipFuncSetAttribute((const void*)mega_fwd, hipFuncAttributeMaxDynamicSharedMemorySize, LDS_BYTES) != hipSuccess) fprintf(stderr, "hipFuncSetAttribute failed\n");
        if (hipOccupancyMaxActiveBlocksPerMultiprocessor(&per_cu, (const void*)mega_fwd, NTHREADS, LDS_BYTES) != hipSuccess || per_cu < 1) { per_cu = 1; (void)hipGetLastError(); }
        grid_blocks = cus * 1;
        if (ws_size < WS_END) fprintf(stderr, "workspace too small: %zu < %zu\n", ws_size, (size_t)WS_END);
    }
    Params p{};
    for (int i = 0; i < 26; ++i) p.in[i] = (const float*)d_in[i];
    p.out = (float*)d_out; p.ws = (unsigned char*)d_ws;
    if (hipMemsetAsync((char*)d_ws + WS_BAR, 0, 16384, stream) != hipSuccess) fprintf(stderr, "memset of barrier words failed\n");
    void* args[] = {&p};
    hipError_t e = hipLaunchCooperativeKernel((void*)mega_fwd, dim3(grid_blocks), dim3(NTHREADS), args, LDS_BYTES, stream);
    if (e != hipSuccess) fprintf(stderr, "cooperative launch failed: %s (grid %d)\n", hipGetErrorString(e), grid_blocks);
}
```

```cpp
#include <hip/hip_runtime.h>
#include <hip/hip_cooperative_groups.h>
#include <cstdio>
namespace cg = cooperative_groups;

#define LAS __attribute__((address_space(3)))
typedef unsigned short bf16_t;
typedef short bf16x8 __attribute__((ext_vector_type(8)));
typedef float f32x4 __attribute__((ext_vector_type(4)));
typedef float f32x2 __attribute__((ext_vector_type(2)));
typedef unsigned u32x4 __attribute__((ext_vector_type(4)));
typedef unsigned u32x2 __attribute__((ext_vector_type(2)));

constexpr int TT = 65536;
constexpr int SEQ = 4096;
constexpr int DM = 1024;
constexpr int FF = 2816;
constexpr int NLAYER = 4;
constexpr int NTHREADS = 512;
constexpr int STAGE_LDS = 131072;
constexpr int RS_LDS = 24576;
constexpr int LDS_BYTES = STAGE_LDS + RS_LDS;

constexpr size_t WS_HB0 = 0;
constexpr size_t WS_HB1 = 134217728ull;
constexpr size_t WS_BIG = 268435456ull;
constexpr size_t BIG_HID = 0, BIG_Z = 0, BIG_PROJ = 0, BIG_MIX = 134217728ull, BIG_YPRE = 268435456ull, BIG_E = 335544320ull;
constexpr size_t BIG_SIZE = 369098752ull;
constexpr size_t WS_PB = WS_BIG + BIG_SIZE;
constexpr size_t WS_W = WS_PB + 33554432ull;
constexpr size_t LW = 20971520ull;
constexpr size_t W_WI1 = 0, W_WO1 = 5767168, W_WIN = 8650752, W_GLU = 9699328, W_OUT = 9961472, W_WI2 = 11010048, W_WO2 = 16777216, W_GATE = 19660800, W_PLE = 20709376;
constexpr size_t WS_SSP0 = WS_W + LW * 2 * NLAYER;
constexpr size_t WS_SSP1 = WS_SSP0 + 4194304ull;
constexpr size_t WS_SSM = WS_SSP1 + 4194304ull;
constexpr size_t SSM_LAMB = 0, SSM_LAMB1K = 16384, SSM_BFRAG = 32768, SSM_CFRAG = 32768 + 131072, SSM_LBYTES = 32768 + 131072 + 131072;
constexpr size_t WS_BAR = WS_SSM + SSM_LBYTES * NLAYER;
constexpr size_t WS_LO = WS_BAR + 16384;
constexpr size_t WS_END = WS_LO + 134217728ull;

struct Params { const float* in[26]; float* out; unsigned char* ws; };
#define GAS __attribute__((address_space(1)))
#define GP(T_, p) ((GAS T_*)(p))

typedef __bf16 bfx2_t __attribute__((ext_vector_type(2)));
__device__ __forceinline__ unsigned cvt_pk_bf16(float lo, float hi) { const f32x2 v = {lo, hi}; return __builtin_bit_cast(unsigned, __builtin_convertvector(v, bfx2_t)); }
__device__ __forceinline__ bf16_t f2bf(float f) { unsigned u = __float_as_uint(f); u += 0x7FFFu + ((u >> 16) & 1u); return (bf16_t)(u >> 16); }
__device__ __forceinline__ float bflo(unsigned w) { return __uint_as_float(w << 16); }
__device__ __forceinline__ float bfhi(unsigned w) { return __uint_as_float(w & 0xffff0000u); }
__device__ __forceinline__ float fsigmoid(float x) { return __builtin_amdgcn_rcpf(1.0f + __builtin_amdgcn_exp2f(-1.4426950408889634f * x)); }


#define XB_TMO      128
#define XB_XCNT(j)  (256  + 64 * (j))
#define XB_XSUB(j)  (1280 + 64 * (j))
#define XB_XGEN(j)  (2304 + 64 * (j))
#define XB_TOP      3328
#define XB_TOPGEN   3392
#define XCD_BAR_WORDS 3456
#define XB_SPIN_CAP (1u << 18)
__device__ __forceinline__ unsigned xb_ld(unsigned* p)              { return __hip_atomic_load(p, __ATOMIC_RELAXED, __HIP_MEMORY_SCOPE_AGENT); }
__device__ __forceinline__ unsigned xb_add(unsigned* p, unsigned v) { return __hip_atomic_fetch_add(p, v, __ATOMIC_RELAXED, __HIP_MEMORY_SCOPE_AGENT); }
__device__ __forceinline__ unsigned xb_xcc_id() { return (unsigned)__builtin_amdgcn_s_getreg((3 << 11) | 20) & 0xFu; }
#define XB_SPIN(cond, bar) do { unsigned _sp = 0; while (cond) { __builtin_amdgcn_s_sleep(1); \
    if ((++_sp & 255u) == 0u) { if (xb_ld(&(bar)[XB_TMO])) break; if (_sp > XB_SPIN_CAP) { atomicAdd(&(bar)[XB_TMO], 1u); break; } } } } while (0)
struct XcdBarrier { unsigned* bar; unsigned x; volatile LAS unsigned* st; };
__device__ __forceinline__ XcdBarrier xcd_barrier_post(unsigned* bar, volatile LAS unsigned* st) {
    XcdBarrier b; b.bar = bar; b.x = xb_xcc_id(); b.st = st;
    if (threadIdx.x == 0) (void)xb_add(&bar[XB_XCNT(b.x)], 1u);
    return b;
}
__device__ __forceinline__ void xcd_barrier_complete(unsigned* bar, unsigned x, unsigned& nloc, unsigned& nx) {
    const unsigned G = gridDim.x * gridDim.y * gridDim.z;
    unsigned sum, cnt, mine, sp = 0u;
    for (;;) {
        sum = 0u; cnt = 0u; mine = 0u;
#pragma unroll
        for (unsigned j = 0; j < 16; ++j) { const unsigned c = xb_ld(&bar[XB_XCNT(j)]); sum += c; cnt += (c > 0u) ? 1u : 0u; mine = (j == x) ? c : mine; }
        if (sum == G) break;
        __builtin_amdgcn_s_sleep(1);
        if ((++sp & 255u) == 0u) { if (xb_ld(&bar[XB_TMO])) break; if (sp > XB_SPIN_CAP) { atomicAdd(&bar[XB_TMO], 1u); break; } }
    }
    nloc = mine > 0u ? mine : 1u; nx = cnt > 0u ? cnt : 1u;
}
__device__ __forceinline__ void xcd_barrier(const XcdBarrier& b) {
    asm volatile("s_waitcnt vmcnt(0)" ::: "memory");
    __syncthreads();
    if (threadIdx.x == 0) {
        unsigned* bar = b.bar;
        __builtin_amdgcn_s_waitcnt(0);
        unsigned nloc = b.st[0], nx = b.st[1];
        if (nloc == 0u) { xcd_barrier_complete(bar, b.x, nloc, nx); b.st[0] = nloc; b.st[1] = nx; }
        const unsigned old = xb_add(&bar[XB_XSUB(b.x)], 1u);
        const unsigned gen = old / nloc;
        if (old + 1u == (gen + 1u) * nloc) {
            __builtin_amdgcn_fence(__ATOMIC_RELEASE, "agent");
            asm volatile("s_waitcnt vmcnt(0)" ::: "memory");
            const unsigned og = xb_add(&bar[XB_TOP], 1u);
            const unsigned tg = og / nx;
            if (og + 1u == (tg + 1u) * nx) xb_add(&bar[XB_TOPGEN], 1u);
            else XB_SPIN(xb_ld(&bar[XB_TOPGEN]) == tg, bar);
            __builtin_amdgcn_fence(__ATOMIC_ACQUIRE, "agent");
            xb_add(&bar[XB_XGEN(b.x)], 1u);
            asm volatile("s_waitcnt vmcnt(0)" ::: "memory");
        } else {
            XB_SPIN(xb_ld(&bar[XB_XGEN(b.x)]) == gen, bar);
            __builtin_amdgcn_fence(__ATOMIC_ACQUIRE, "agent");
            asm volatile("s_waitcnt vmcnt(0)" ::: "memory");
        }
    }
    __syncthreads();
}

namespace pg8 {
constexpr int BM = 256, BK = 64, HALF = 128, HTB = HALF * BK * 2, NXCD = 8, WGM = 8;
__device__ __forceinline__ int lds_byte(int r, int c) { const int st = (r >> 4) * 2 + (c >> 5), rr = r & 15, cc = c & 31, ob = rr * 64 + cc * 2; return st * 1024 + (ob ^ (((ob >> 9) & 1) << 5)); }
__device__ __forceinline__ void stage_rc(int b, int& R, int& C) { const int st = b / 1024, sb = b % 1024, swz = sb ^ (((sb >> 9) & 1) << 5); R = (st >> 1) * 16 + swz / 64; C = (st & 1) * 32 + (swz % 64) / 2; }
__device__ __forceinline__ int perm32(int rho) { const int n = rho >> 4, i = rho & 15; return 8 * (i >> 2) + 4 * n + (i & 3); }
struct Unit { int pm, pn; };
struct Gemm { const bf16_t* A; const bf16_t* Bt; int M, N, K; };
struct StaticOrder {
    int nM, nN, nwg, G, c;
    __device__ void init(int M, int N, int G_, int c_) { nM = M / BM; nN = N / BM; nwg = nM * nN; G = G_; c = c_; }
    __device__ bool next(int i, Unit& u) const {
        const long L = (long)i * G + c; if (L >= nwg) return false;
        int wgid = (int)L; { const int q = nwg / NXCD, r = nwg % NXCD, xcd = wgid % NXCD, off = wgid / NXCD; wgid = (xcd < r ? xcd * (q + 1) : r * (q + 1) + (xcd - r) * q) + off; }
        const int nig = WGM * nN, gid = wgid / nig, fm = gid * WGM, gsz = (nM - fm) < WGM ? (nM - fm) : WGM;
        u.pm = fm + ((wgid % nig) % gsz); u.pn = (wgid % nig) / gsz; return true;
    }
};
struct RevOrder : StaticOrder { __device__ bool next(int i, Unit& u) const { const int nr = (nwg + G - 1) / G; if (i < 0 || i >= nr) return false; return StaticOrder::next(nr - 1 - i, u); } };
template <class Epi, class Ord>
__device__ __forceinline__ void gemm_phase(LAS unsigned char* lds, const Gemm g, const Ord& S, const Epi& E) {
    int tid = threadIdx.x; asm volatile("" : "+v"(tid));
    const int wid = __builtin_amdgcn_readfirstlane(tid >> 6), lane = tid & 63, wr = wid >> 2, wc = wid & 3, fr = lane & 15, fq = lane >> 4;
    int K = g.K; asm volatile("" : "+s"(K));
    const int nt = K / BK;
    unsigned voffA[2], voffB[2];
#pragma unroll
    for (int i = 0; i < 2; ++i) { int R, C; stage_rc(tid * 16 + i * 8192, R, C); const int Rb = (R & ~31) + perm32(R & 31);
        voffA[i] = (unsigned)(R * K + C) * 2u; voffB[i] = (unsigned)(Rb * K + C) * 2u; }
    const size_t kstep = (size_t)(BK * 2);
    const size_t hstep = (size_t)HALF * K * 2;
    const size_t tstep = 2 * hstep;
    const unsigned ldsw = (unsigned)wid * 1024u;
    const int aoff = lds_byte(wr * 64 + fr, fq * 8), boff = lds_byte(wc * 32 + fr, fq * 8);
#define PG8_SA(b, h) (((b) * 2 + (h)) * HTB)
#define PG8_SB(b, h) ((4 + (b) * 2 + (h)) * HTB)
#define PG8_STAGE(bufoff, gbase, voff) do { const char* _gb = (const char*)(gbase); asm volatile("" : "+s"(_gb)); _Pragma("unroll") for (int _i = 0; _i < 2; ++_i) { unsigned _vo = (voff)[_i]; asm volatile("" : "+v"(_vo)); \
        __builtin_amdgcn_global_load_lds((const GAS unsigned*)(_gb + _vo), (LAS unsigned*)(lds + (bufoff) + ldsw + _i * 8192), 16, 0, 0); } } while (0)
#define PG8_LDA(dst, b, h) do { _Pragma("unroll") for (int m = 0; m < 4; ++m) _Pragma("unroll") for (int k = 0; k < 2; ++k) dst[m][k] = *(const LAS bf16x8*)(lds + PG8_SA(b, h) + aoff + m * 2048 + k * 1024); } while (0)
#define PG8_LDB(dst, b, h) do { _Pragma("unroll") for (int n = 0; n < 2; ++n) _Pragma("unroll") for (int k = 0; k < 2; ++k) dst[n][k] = *(const LAS bf16x8*)(lds + PG8_SB(b, h) + boff + n * 2048 + k * 1024); } while (0)
#define PG8_MMA(ai, bj, At, Bt) do { __builtin_amdgcn_s_setprio(1); _Pragma("unroll") for (int m = 0; m < 4; ++m) _Pragma("unroll") for (int n = 0; n < 2; ++n) _Pragma("unroll") for (int k = 0; k < 2; ++k) \
        acc[ai][bj][m][n] = __builtin_amdgcn_mfma_f32_16x16x32_bf16(Bt[n][k], At[m][k], acc[ai][bj][m][n], 0, 0, 0); __builtin_amdgcn_s_setprio(0); } while (0)
#define PG8_WAIT_V(n) asm volatile("s_waitcnt vmcnt(" #n ")" ::: "memory")
#define PG8_WAIT_L(n) asm volatile("s_waitcnt lgkmcnt(" #n ")" ::: "memory")
#define PG8_BAR __builtin_amdgcn_s_barrier()
#define PG8_SCHED __builtin_amdgcn_sched_barrier(0)
    Unit cur, nxt; int ui = 0;
    if (!S.next(0, cur)) return;
    f32x4 acc[2][2][4][2];
#pragma unroll
    for (int a = 0; a < 2; ++a)
#pragma unroll
        for (int b = 0; b < 2; ++b)
#pragma unroll
            for (int m = 0; m < 4; ++m)
#pragma unroll
                for (int n = 0; n < 2; ++n) acc[a][b][m][n] = (f32x4){0.f, 0.f, 0.f, 0.f};
    bf16x8 At[4][2], B0[2][2], B1[2][2];
    const char* cA = (const char*)g.A + (size_t)cur.pm * tstep; const char* cB = (const char*)g.Bt + (size_t)cur.pn * tstep;
    PG8_STAGE(PG8_SB(0, 0), cB, voffB); PG8_STAGE(PG8_SA(0, 0), cA, voffA); PG8_STAGE(PG8_SB(0, 1), cB + hstep, voffB); PG8_STAGE(PG8_SA(0, 1), cA + hstep, voffA);
    if (wr == 1) PG8_BAR;
    PG8_WAIT_V(4); PG8_BAR;
    PG8_STAGE(PG8_SB(1, 0), cB + kstep, voffB); PG8_STAGE(PG8_SA(1, 0), cA + kstep, voffA); PG8_STAGE(PG8_SB(1, 1), cB + hstep + kstep, voffB);
    PG8_WAIT_V(6); PG8_BAR;
    for (;;) {
        const bool has_next = S.next(ui + 1, nxt);
        const char* nA = has_next ? (const char*)g.A + (size_t)nxt.pm * tstep : cA; const char* nB = has_next ? (const char*)g.Bt + (size_t)nxt.pn * tstep : cB;
#pragma nounroll
        for (int t = 0; t < nt; t += 2) {
            const bool last = (t == nt - 2);
            const char* a1 = cA + (size_t)(t + 1) * kstep;
            const char* a2 = last ? nA : cA + (size_t)(t + 2) * kstep; const char* b2 = last ? nB : cB + (size_t)(t + 2) * kstep;
            const char* a3 = a2 + kstep; const char* b3 = b2 + kstep;
            PG8_LDB(B0, 0, 0); PG8_SCHED; PG8_LDA(At, 0, 0); PG8_STAGE(PG8_SA(1, 1), a1 + hstep, voffA);
            PG8_WAIT_L(8); PG8_BAR; PG8_WAIT_L(0); PG8_MMA(0, 0, At, B0); PG8_BAR; PG8_SCHED;
            PG8_LDB(B1, 0, 1); PG8_STAGE(PG8_SB(0, 0), b2, voffB);
            PG8_BAR; PG8_WAIT_L(0); PG8_MMA(0, 1, At, B1); PG8_BAR;
            PG8_LDA(At, 0, 1); PG8_STAGE(PG8_SA(0, 0), a2, voffA);
            PG8_BAR; PG8_WAIT_L(0); PG8_MMA(1, 0, At, B0); PG8_BAR; PG8_SCHED;
            PG8_STAGE(PG8_SB(0, 1), b2 + hstep, voffB);
            PG8_WAIT_V(6); PG8_BAR; PG8_MMA(1, 1, At, B1); PG8_BAR;
            PG8_LDB(B0, 1, 0); PG8_SCHED; PG8_LDA(At, 1, 0); PG8_STAGE(PG8_SA(0, 1), a2 + hstep, voffA);
            PG8_WAIT_L(8); PG8_BAR; PG8_WAIT_L(0); PG8_MMA(0, 0, At, B0); PG8_BAR; PG8_SCHED;
            PG8_LDB(B1, 1, 1); PG8_STAGE(PG8_SB(1, 0), b3, voffB);
            PG8_BAR; PG8_WAIT_L(0); PG8_MMA(0, 1, At, B1); PG8_BAR;
            PG8_LDA(At, 1, 1); PG8_STAGE(PG8_SA(1, 0), a3, voffA);
            PG8_BAR; PG8_WAIT_L(0); PG8_MMA(1, 0, At, B0); PG8_BAR; PG8_SCHED;
            PG8_STAGE(PG8_SB(1, 1), b3 + hstep, voffB);
            PG8_WAIT_V(6); PG8_BAR; PG8_MMA(1, 1, At, B1); PG8_BAR;
        }
        E(acc, cur, ui, wr, wc, fr, fq);
        if (!has_next) break;
#pragma unroll
        for (int a = 0; a < 2; ++a)
#pragma unroll
            for (int b = 0; b < 2; ++b)
#pragma unroll
                for (int m = 0; m < 4; ++m)
#pragma unroll
                    for (int n = 0; n < 2; ++n) acc[a][b][m][n] = (f32x4){0.f, 0.f, 0.f, 0.f};
        cur = nxt; cA = nA; cB = nB; ++ui;
    }
    PG8_WAIT_V(0);
    if (wr == 0) PG8_BAR;
    PG8_BAR;
#undef PG8_SA
#undef PG8_SB
#undef PG8_STAGE
#undef PG8_LDA
#undef PG8_LDB
#undef PG8_MMA
#undef PG8_WAIT_V
#undef PG8_WAIT_L
#undef PG8_BAR
#undef PG8_SCHED
}
}
using pg8::Unit;
typedef f32x4 AccT[2][2][4][2];

struct EpiSwiGLU {
    bf16_t* O; const LAS float* rs;
    __device__ __forceinline__ void operator()(const AccT& acc, const Unit& u, int ui, int wr, int wc, int fr, int fq) const {
        const int col = u.pn * 128 + wc * 32 + 8 * fq;
#pragma unroll
        for (int ai = 0; ai < 2; ++ai)
#pragma unroll
            for (int m = 0; m < 4; ++m) {
                const int rl = ai * 128 + wr * 64 + m * 16 + fr; const float r = rs[((u.pm >> 3) & 3) * 256 + rl];
                const float nr = -1.4426950408889634f * r, r2 = r * r;
                unsigned w[4];
#pragma unroll
                for (int n = 0; n < 2; ++n)
#pragma unroll
                    for (int hlf = 0; hlf < 2; ++hlf) {
                        const f32x2 a = {acc[ai][0][m][n][2 * hlf], acc[ai][0][m][n][2 * hlf + 1]}, b = {acc[ai][1][m][n][2 * hlf], acc[ai][1][m][n][2 * hlf + 1]};
                        const f32x2 t = a * nr;
                        f32x2 d; d.x = __builtin_amdgcn_exp2f(t.x); d.y = __builtin_amdgcn_exp2f(t.y); d = d + 1.0f;
                        f32x2 q; q.x = __builtin_amdgcn_rcpf(d.x); q.y = __builtin_amdgcn_rcpf(d.y);
                        const f32x2 o = ((a * b) * r2) * q;
                        w[n * 2 + hlf] = cvt_pk_bf16(o.x, o.y);
                    }
                u32x4 wv; wv.x = w[0]; wv.y = w[1]; wv.z = w[2]; wv.w = w[3];
                *GP(u32x4, O + (size_t)(u.pm * 256 + rl) * FF + col) = wv;
            }
    }
};
template <int MODE> struct EpiH {
    const bf16_t* hin; bf16_t* hout; bf16_t* lo; float* ssp; float alpha; const bf16_t* proj; const LAS float* rs;
    template <int NM> __device__ __forceinline__ void round(const AccT& acc, const Unit& u, int ai, int m0, int wr, int wc, int fr, int fq) const {
        u32x4 hv[NM][2], lv[NM][2], pv[NM][2];
#pragma unroll
        for (int mm = 0; mm < NM; ++mm) {
            const int rl = ai * 128 + wr * 64 + (m0 + mm) * 16 + fr;
            const size_t off = (size_t)(u.pm * 256 + rl) * DM + u.pn * 256 + wc * 32 + 8 * fq;
#pragma unroll
            for (int bj = 0; bj < 2; ++bj) {
                hv[mm][bj] = *GP(const u32x4, hin + off + bj * 128); lv[mm][bj] = *GP(const u32x4, lo + off + bj * 128);
                if (MODE == 1) pv[mm][bj] = *GP(const u32x4, proj + off + bj * 128);
            }
        }
#pragma unroll
        for (int mm = 0; mm < NM; ++mm) {
            const int m = m0 + mm;
            const int rl = ai * 128 + wr * 64 + m * 16 + fr; const int row = u.pm * 256 + rl;
            const size_t off = (size_t)row * DM + u.pn * 256 + wc * 32 + 8 * fq;
            float r = 1.f; if (MODE == 1) r = rs[((u.pm >> 3) & 3) * 256 + rl];
            float ss = 0.f;
#pragma unroll
            for (int bj = 0; bj < 2; ++bj) {
                f32x4 d0, d1;
                if (MODE == 0) { d0 = acc[ai][bj][m][0] * alpha; d1 = acc[ai][bj][m][1] * alpha; }
                else {
                    const u32x4 p = pv[mm][bj];
                    const f32x4 a0 = acc[ai][bj][m][0] * r, a1 = acc[ai][bj][m][1] * r;
                    d0 = (f32x4){fsigmoid(a0[0]) * bflo(p.x), fsigmoid(a0[1]) * bfhi(p.x), fsigmoid(a0[2]) * bflo(p.y), fsigmoid(a0[3]) * bfhi(p.y)};
                    d1 = (f32x4){fsigmoid(a1[0]) * bflo(p.z), fsigmoid(a1[1]) * bfhi(p.z), fsigmoid(a1[2]) * bflo(p.w), fsigmoid(a1[3]) * bfhi(p.w)};
                }
                const u32x4 H = hv[mm][bj], L = lv[mm][bj];
                const f32x4 o0 = (f32x4){bflo(H.x) + bflo(L.x), bfhi(H.x) + bfhi(L.x), bflo(H.y) + bflo(L.y), bfhi(H.y) + bfhi(L.y)} + d0;
                const f32x4 o1 = (f32x4){bflo(H.z) + bflo(L.z), bfhi(H.z) + bfhi(L.z), bflo(H.w) + bflo(L.w), bfhi(H.w) + bfhi(L.w)} + d1;
                u32x4 w; w.x = cvt_pk_bf16(o0[0], o0[1]); w.y = cvt_pk_bf16(o0[2], o0[3]); w.z = cvt_pk_bf16(o1[0], o1[1]); w.w = cvt_pk_bf16(o1[2], o1[3]);
                u32x4 wl; wl.x = cvt_pk_bf16(o0[0] - bflo(w.x), o0[1] - bfhi(w.x)); wl.y = cvt_pk_bf16(o0[2] - bflo(w.y), o0[3] - bfhi(w.y));
                wl.z = cvt_pk_bf16(o1[0] - bflo(w.z), o1[1] - bfhi(w.z)); wl.w = cvt_pk_bf16(o1[2] - bflo(w.w), o1[3] - bfhi(w.w));
                *GP(u32x4, hout + off + bj * 128) = w; *GP(u32x4, lo + off + bj * 128) = wl;
                ss += (o0[0] * o0[0] + o0[1] * o0[1]) + (o0[2] * o0[2] + o0[3] * o0[3]) + (o1[0] * o1[0] + o1[1] * o1[1]) + (o1[2] * o1[2] + o1[3] * o1[3]);
            }
            ss += __shfl_xor(ss, 16); ss += __shfl_xor(ss, 32);
            if (fq == 0) *GP(float, ssp + (size_t)(u.pn * 4 + wc) * TT + row) = ss;
        }
        asm volatile("" ::: "memory");
    }
    __device__ __forceinline__ void operator()(const AccT& acc, const Unit& u, int ui, int wr, int wc, int fr, int fq) const {
        if (MODE == 0) { round<4>(acc, u, 0, 0, wr, wc, fr, fq); round<4>(acc, u, 1, 0, wr, wc, fr, fq); }
        else { round<2>(acc, u, 0, 0, wr, wc, fr, fq); round<2>(acc, u, 0, 2, wr, wc, fr, fq); round<2>(acc, u, 1, 0, wr, wc, fr, fq); round<2>(acc, u, 1, 2, wr, wc, fr, fq); }
    }
};
struct EpiZ {
    bf16_t* Z; const LAS float* rs;
    __device__ __forceinline__ void operator()(const AccT& acc, const Unit& u, int ui, int wr, int wc, int fr, int fq) const {
#pragma unroll
        for (int ai = 0; ai < 2; ++ai)
#pragma unroll
            for (int m = 0; m < 4; ++m) {
                const int rl = ai * 128 + wr * 64 + m * 16 + fr; const float r = rs[((u.pm >> 3) & 3) * 256 + rl];
                bf16_t* p = Z + (size_t)(u.pm * 256 + rl) * DM + u.pn * 256 + wc * 32 + 8 * fq;
#pragma unroll
                for (int bj = 0; bj < 2; ++bj) { const f32x4 a0 = acc[ai][bj][m][0] * r, a1 = acc[ai][bj][m][1] * r;
                    u32x4 w; w.x = cvt_pk_bf16(a0[0], a0[1]); w.y = cvt_pk_bf16(a0[2], a0[3]); w.z = cvt_pk_bf16(a1[0], a1[1]); w.w = cvt_pk_bf16(a1[2], a1[3]);
                    *GP(u32x4, p + bj * 128) = w; }
            }
    }
};
struct EpiGLU {
    const bf16_t* Y; bf16_t* MIX;
    __device__ __forceinline__ void operator()(const AccT& acc, const Unit& u, int ui, int wr, int wc, int fr, int fq) const {
#pragma unroll
        for (int ai = 0; ai < 2; ++ai) {
            u32x4 yv[4][2];
#pragma unroll
            for (int m = 0; m < 4; ++m)
#pragma unroll
                for (int bj = 0; bj < 2; ++bj) yv[m][bj] = *GP(const u32x4, Y + (size_t)(u.pm * 256 + ai * 128 + wr * 64 + m * 16 + fr) * 512 + u.pn * 256 + bj * 128 + wc * 32 + 8 * fq);
#pragma unroll
            for (int m = 0; m < 4; ++m) {
                const int row = u.pm * 256 + ai * 128 + wr * 64 + m * 16 + fr;
#pragma unroll
                for (int bj = 0; bj < 2; ++bj) {
                    const int col = u.pn * 256 + bj * 128 + wc * 32 + 8 * fq;
                    const u32x4 y = yv[m][bj];
                    const f32x4 a0 = acc[ai][bj][m][0], a1 = acc[ai][bj][m][1];
                    u32x4 w;
                    w.x = cvt_pk_bf16(bflo(y.x) * fsigmoid(a0[0]), bfhi(y.x) * fsigmoid(a0[1]));
                    w.y = cvt_pk_bf16(bflo(y.y) * fsigmoid(a0[2]), bfhi(y.y) * fsigmoid(a0[3]));
                    w.z = cvt_pk_bf16(bflo(y.z) * fsigmoid(a1[0]), bfhi(y.z) * fsigmoid(a1[1]));
                    w.w = cvt_pk_bf16(bflo(y.w) * fsigmoid(a1[2]), bfhi(y.w) * fsigmoid(a1[3]));
                    *GP(u32x4, MIX + (size_t)row * DM + col) = w;
                }
            }
            asm volatile("" ::: "memory");
        }
    }
};
struct EpiProj {
    bf16_t* O;
    __device__ __forceinline__ void operator()(const AccT& acc, const Unit& u, int ui, int wr, int wc, int fr, int fq) const {
#pragma unroll
        for (int ai = 0; ai < 2; ++ai)
#pragma unroll
            for (int m = 0; m < 4; ++m) {
                const int row = u.pm * 256 + ai * 128 + wr * 64 + m * 16 + fr;
                bf16_t* p = O + (size_t)row * DM + u.pn * 256 + wc * 32 + 8 * fq;
#pragma unroll
                for (int bj = 0; bj < 2; ++bj) {
                    const f32x4 a0 = acc[ai][bj][m][0], a1 = acc[ai][bj][m][1];
                    u32x4 w; w.x = cvt_pk_bf16(a0[0], a0[1]); w.y = cvt_pk_bf16(a0[2], a0[3]); w.z = cvt_pk_bf16(a1[0], a1[1]); w.w = cvt_pk_bf16(a1[2], a1[3]);
                    *GP(u32x4, p + bj * 128) = w;
                }
            }
    }
};

__device__ __forceinline__ void build_rs(LAS float* rs, const float* ssp) {
    int tid = threadIdx.x, c = blockIdx.x; asm volatile("" : "+v"(tid), "+s"(c));
#pragma unroll
    for (int e2 = 0; e2 < 2; ++e2) {
        const int e = tid + e2 * NTHREADS, slot = e >> 8, t = e & 255;
        const int pm = 32 * (c & 7) + 8 * slot + ((c >> 3) & 7); const int row = pm * 256 + t; float sacc = 0.f;
#pragma unroll
        for (int q = 0; q < 16; ++q) sacc += *GP(const float, ssp + (size_t)q * TT + row);
        rs[slot * 256 + t] = 1.0f / sqrtf(sacc * (1.0f / 1024.0f) + 1e-6f);
    }
    __syncthreads();
}

__device__ __forceinline__ void convT_tile(const float* src, int ldsrc, const float* sc, bf16_t* dst, int dstld, int k0, int n0, int swiglu, LAS float* t) {
    const int tid = threadIdx.x;
    { const int r = tid >> 6, c4 = (tid & 63) * 4;
      int ncol = n0 + c4; if (swiglu) { const int blk = n0 >> 8; ncol = (c4 < 128) ? (128 * blk + c4) : (FF + 128 * blk + (c4 - 128)); }
      f32x4 v[8]; float sv[8];
#pragma unroll
      for (int i = 0; i < 8; ++i) { const int rr = r + 8 * i; v[i] = *(const f32x4*)(src + (size_t)(k0 + rr) * ldsrc + ncol); sv[i] = sc ? sc[k0 + rr] : 1.0f; }
#pragma unroll
      for (int i = 0; i < 8; ++i) { const int rr = r + 8 * i; t[rr * 257 + c4 + 0] = v[i][0] * sv[i]; t[rr * 257 + c4 + 1] = v[i][1] * sv[i]; t[rr * 257 + c4 + 2] = v[i][2] * sv[i]; t[rr * 257 + c4 + 3] = v[i][3] * sv[i]; } }
    __syncthreads();
    { const int nn = tid >> 1, kh = (tid & 1) * 32;
#pragma unroll
      for (int q = 0; q < 4; ++q) { float v[8];
#pragma unroll
          for (int j = 0; j < 8; ++j) v[j] = t[(kh + q * 8 + j) * 257 + nn];
          u32x4 w; w.x = cvt_pk_bf16(v[0], v[1]); w.y = cvt_pk_bf16(v[2], v[3]); w.z = cvt_pk_bf16(v[4], v[5]); w.w = cvt_pk_bf16(v[6], v[7]);
          *(u32x4*)(dst + (size_t)(n0 + nn) * dstld + k0 + kh + q * 8) = w; } }
    __syncthreads();
}
__device__ __forceinline__ void convT(const float* src, int ldsrc, const float* sc, bf16_t* dst, int dstld, int Krows, int Ncols, int swiglu, LAS float* t, int& base) {
    const int G = gridDim.x, nkt = Krows / 64, ntiles = nkt * (Ncols / 256);
    int first = ((int)blockIdx.x - (base % G) + G) % G;
    for (int idx = first; idx < ntiles; idx += G) {
        const int kt = idx % nkt, ntile = idx / nkt;
        convT_tile(src, ldsrc, sc, dst, dstld, kt * 64, ntile * 256, swiglu, t);
    }
    base += ntiles;
}
__device__ __forceinline__ void conv_poolout(const float* pw, const float* pscale, const float* wout, bf16_t* dst, LAS float* t, int& base) {
    const int G = gridDim.x, tid = threadIdx.x, ntiles = 8 * 16;
    int first = ((int)blockIdx.x - (base % G) + G) % G;
    for (int idx = first; idx < ntiles; idx += G) {
        const int k0 = (idx & 7) * 64, n0 = (idx >> 3) * 64;
        const int tn = tid & 63, tk = tid >> 6; const int kb = k0 + tk * 8; const int gi = kb >> 7, kk0 = kb & 127;
        float a[8];
#pragma unroll
        for (int i = 0; i < 8; ++i) a[i] = 0.f;
        const float* pwg = pw + (size_t)gi * 128 * 128 + (size_t)kk0 * 128;
        for (int m = 0; m < 128; ++m) {
            const float w = wout[(size_t)(512 + gi * 128 + m) * DM + n0 + tn] * pscale[gi * 128 + m];
#pragma unroll
            for (int i = 0; i < 8; ++i) a[i] += pwg[i * 128 + m] * w;
        }
#pragma unroll
        for (int i = 0; i < 8; ++i) t[(tk * 8 + i) * 65 + tn] = a[i];
        __syncthreads();
        { const int nn = tid >> 3, k8 = (tid & 7) * 8; float v[8];
#pragma unroll
          for (int j = 0; j < 8; ++j) v[j] = t[(k8 + j) * 65 + nn];
          u32x4 w; w.x = cvt_pk_bf16(v[0], v[1]); w.y = cvt_pk_bf16(v[2], v[3]); w.z = cvt_pk_bf16(v[4], v[5]); w.w = cvt_pk_bf16(v[6], v[7]);
          *(u32x4*)(dst + (size_t)(n0 + nn) * DM + 512 + k0 + k8) = w; }
        __syncthreads();
    }
    base += ntiles;
}

__device__ __forceinline__ void dsincos(double th, double& s, double& c) {
    const double k = rint(th * 0.63661977236758134308);
    const double r = (th - k * 1.57079632679489655800) - k * 6.123233995736766e-17;
    const double r2 = r * r;
    const double sp = r * (1.0 + r2 * (-1.0 / 6 + r2 * (1.0 / 120 + r2 * (-1.0 / 5040 + r2 * (1.0 / 362880 + r2 * (-1.0 / 39916800 + r2 * (1.0 / 6227020800.0)))))));
    const double cp = 1.0 + r2 * (-0.5 + r2 * (1.0 / 24 + r2 * (-1.0 / 720 + r2 * (1.0 / 40320 + r2 * (-1.0 / 3628800 + r2 * (1.0 / 479001600.0 + r2 * (-1.0 / 87178291200.0)))))));
    const int q = ((int)k) & 3;
    s = (q == 0) ? sp : (q == 1) ? cp : (q == 2) ? -sp : -cp;
    c = (q == 0) ? cp : (q == 1) ? -sp : (q == 2) ? -cp : sp;
}

__device__ void prologue(const Params& P, LAS unsigned char* lds) {
    const int tid = threadIdx.x, lane = tid & 63, wave = tid >> 6, G = gridDim.x;
    unsigned char* ws = P.ws;
    {
        const float* x = P.in[0]; bf16_t* hb = (bf16_t*)(ws + WS_HB0); bf16_t* lo = (bf16_t*)(ws + WS_LO); float* ssp = (float*)(ws + WS_SSP0);
        for (int row = blockIdx.x * 8 + wave; row < TT; row += G * 8) {
            float ss = 0.f;
#pragma unroll
            for (int q = 0; q < 4; ++q) { const f32x4 v = *(const f32x4*)(x + (size_t)row * DM + q * 256 + lane * 4);
                ss += (v[0] * v[0] + v[1] * v[1]) + (v[2] * v[2] + v[3] * v[3]);
                u32x2 w; w.x = cvt_pk_bf16(v[0], v[1]); w.y = cvt_pk_bf16(v[2], v[3]); *(u32x2*)(hb + (size_t)row * DM + q * 256 + lane * 4) = w;
                u32x2 wl; wl.x = cvt_pk_bf16(v[0] - bflo(w.x), v[1] - bfhi(w.x)); wl.y = cvt_pk_bf16(v[2] - bflo(w.y), v[3] - bfhi(w.y)); *(u32x2*)(lo + (size_t)row * DM + q * 256 + lane * 4) = wl; }
#pragma unroll
            for (int o = 32; o >= 1; o >>= 1) ss += __shfl_xor(ss, o);
            if (lane < 16) ssp[(size_t)lane * TT + row] = (lane == 0) ? ss : 0.f;
        }
    }
    {
        LAS float* t = (LAS float*)lds; int base = 0;
        for (int l = 0; l < NLAYER; ++l) {
            bf16_t* W = (bf16_t*)(ws + WS_W) + (size_t)l * LW;
            convT(P.in[3] + (size_t)l * DM * 2 * FF, 2 * FF, P.in[2] + l * DM, W + W_WI1, DM, DM, 2 * FF, 1, t, base);
            convT(P.in[4] + (size_t)l * FF * DM, DM, nullptr, W + W_WO1, FF, FF, DM, 0, t, base);
            convT(P.in[6] + (size_t)l * DM * DM, DM, P.in[5] + l * DM, W + W_WIN, DM, DM, DM, 0, t, base);
            convT(P.in[15] + (size_t)l * 512 * 512, 512, nullptr, W + W_GLU, 512, 512, 512, 0, t, base);
            convT(P.in[18] + (size_t)l * DM * DM, DM, nullptr, W + W_OUT, DM, 512, DM, 0, t, base);
            conv_poolout(P.in[16] + (size_t)l * 4 * 128 * 128, P.in[17] + l * 512, P.in[18] + (size_t)l * DM * DM, W + W_OUT, t, base);
            convT(P.in[20] + (size_t)l * DM * 2 * FF, 2 * FF, P.in[19] + l * DM, W + W_WI2, DM, DM, 2 * FF, 1, t, base);
            convT(P.in[21] + (size_t)l * FF * DM, DM, nullptr, W + W_WO2, FF, FF, DM, 0, t, base);
            convT(P.in[23] + (size_t)l * DM * DM, DM, P.in[22] + l * DM, W + W_GATE, DM, DM, DM, 0, t, base);
            convT(P.in[24] + (size_t)l * 256 * DM, DM, nullptr, W + W_PLE, 256, 256, DM, 0, t, base);
        }
    }
    {
        const int gt = blockIdx.x * NTHREADS + tid, nthr = G * NTHREADS;
        for (int it = gt; it < NLAYER * 2048; it += nthr) {
            const int l = it >> 11, gp = it & 2047, g = gp >> 6;
            const double lr = P.in[7][it], li = P.in[8][it]; const double dt = (double)expf(P.in[9][l * 32 + g]);
            double sn, cs; dsincos(li * dt, sn, cs); const double mag = (double)expf((float)(lr * dt));
            const float ar = (float)(mag * cs), ai = (float)(mag * sn);
            unsigned char* sb = ws + WS_SSM + (size_t)l * SSM_LBYTES;
            ((float*)(sb + SSM_LAMB))[gp * 2] = ar; ((float*)(sb + SSM_LAMB))[gp * 2 + 1] = ai;
            double pr = ar, pi = ai;
#pragma unroll
            for (int s = 0; s < 10; ++s) { const double nr = pr * pr - pi * pi, ni = 2.0 * pr * pi; pr = nr; pi = ni; }
            ((float*)(sb + SSM_LAMB1K))[gp * 2] = (float)pr; ((float*)(sb + SSM_LAMB1K))[gp * 2 + 1] = (float)pi;
            const double nr = mag * cs - 1.0, ni = mag * sn, den = lr * lr + li * li;
            const double qr = (nr * lr + ni * li) / den, qi = (ni * lr - nr * li) / den;
            bf16_t* Bf = (bf16_t*)(sb + SSM_BFRAG) + (size_t)g * 8 * 64 * 4;
            const float* bre = P.in[10] + (size_t)it * 16; const float* bim = P.in[11] + (size_t)it * 16;
            const int p = gp & 63, tq = p >> 4, frr = p & 15;
#pragma unroll
            for (int hh = 0; hh < 16; ++hh) { const double br = bre[hh], bi = bim[hh]; const int ln = (hh >> 2) * 16 + frr, i = hh & 3;
                Bf[((size_t)tq * 64 + ln) * 4 + i] = f2bf((float)(qr * br - qi * bi)); Bf[((size_t)(tq + 4) * 64 + ln) * 4 + i] = f2bf((float)(qr * bi + qi * br)); }
        }
        for (int it = gt; it < NLAYER * 32 * 4 * 64 * 8; it += nthr) {
            const int i = it & 7, ln = (it >> 3) & 63, kt = (it >> 9) & 3, g = (it >> 11) & 31, l = it >> 16;
            const int hh = ln & 15, k = 32 * kt + 8 * (ln >> 4) + i, p = k >> 1;
            const size_t ci = (((size_t)l * 32 + g) * 16 + hh) * 64 + p;
            const float v = (k & 1) ? -P.in[13][ci] : P.in[12][ci];
            ((bf16_t*)(ws + WS_SSM + (size_t)l * SSM_LBYTES + SSM_CFRAG))[it & 65535] = f2bf(v);
        }
    }
}

__device__ __forceinline__ void conv_p(const Params& P, int l) {
    const float* src = P.in[1] + (size_t)l * TT * 256; bf16_t* dst = (bf16_t*)(P.ws + WS_PB);
    const size_t n8 = (size_t)TT * 256 / 8, stride = (size_t)gridDim.x * NTHREADS;
    size_t i = (size_t)blockIdx.x * NTHREADS + threadIdx.x;
    for (; i + 3 * stride < n8; i += 4 * stride) {
        f32x4 a[4], b[4];
#pragma unroll
        for (int q = 0; q < 4; ++q) { a[q] = *(const f32x4*)(src + (i + q * stride) * 8); b[q] = *(const f32x4*)(src + (i + q * stride) * 8 + 4); }
#pragma unroll
        for (int q = 0; q < 4; ++q) { u32x4 w; w.x = cvt_pk_bf16(a[q][0], a[q][1]); w.y = cvt_pk_bf16(a[q][2], a[q][3]); w.z = cvt_pk_bf16(b[q][0], b[q][1]); w.w = cvt_pk_bf16(b[q][2], b[q][3]);
            *(u32x4*)(dst + (i + q * stride) * 8) = w; }
    }
    for (; i < n8; i += stride) {
        const f32x4 a = *(const f32x4*)(src + i * 8), b = *(const f32x4*)(src + i * 8 + 4);
        u32x4 w; w.x = cvt_pk_bf16(a[0], a[1]); w.y = cvt_pk_bf16(a[2], a[3]); w.z = cvt_pk_bf16(b[0], b[1]); w.w = cvt_pk_bf16(b[2], b[3]);
        *(u32x4*)(dst + i * 8) = w;
    }
}

typedef short bf16x4 __attribute__((ext_vector_type(4)));
template <int PASS> __device__ void ssm_pass(const Params& P, int l, LAS unsigned char* lds) {
    int tid = threadIdx.x; asm volatile("" : "+v"(tid));
    const int lane = tid & 63, wave = __builtin_amdgcn_readfirstlane(tid >> 6), G = gridDim.x, fr = lane & 15, fq = lane >> 4;
    unsigned char* ws = P.ws;
    const bf16_t* z = (const bf16_t*)(ws + WS_BIG + BIG_Z); float* E = (float*)(ws + WS_BIG + BIG_E); bf16_t* ypre = (bf16_t*)(ws + WS_BIG + BIG_YPRE);
    const unsigned char* sb = ws + WS_SSM + (size_t)l * SSM_LBYTES;
    const float* lamb = (const float*)(sb + SSM_LAMB); const float* lamb1k = (const float*)(sb + SSM_LAMB1K);
    const bf16_t* Bfrag = (const bf16_t*)(sb + SSM_BFRAG); const bf16_t* Cfrag = (const bf16_t*)(sb + SSM_CFRAG); const float* dskip = P.in[14] + l * 512;
    LAS unsigned char* BU = lds + wave * 12800;
    LAS unsigned char* SI = BU + 8448;
    for (int unit = blockIdx.x; unit < 256; unit += G) {
        const int b = unit >> 4, r = (unit >> 2) & 3, g = (unit & 3) * 8 + wave;
        const size_t tok0 = (size_t)b * SEQ + r * 1024;
        const f32x2 a = *(const f32x2*)(lamb + (g * 64 + lane) * 2);
        bf16x4 bf[8];
#pragma unroll
        for (int t = 0; t < 8; ++t) bf[t] = *(const bf16x4*)(Bfrag + ((size_t)(g * 8 + t) * 64 + lane) * 4);
        float sr = 0.f, si = 0.f;
        bf16x8 cf[4]; f32x4 dd;
        if (PASS == 2) {
            const f32x2 a1k = *(const f32x2*)(lamb1k + (g * 64 + lane) * 2);
            for (int rr = 0; rr < r; ++rr) { const f32x2 e = *(const f32x2*)(E + ((size_t)((b * 32 + g) * 4 + rr) * 64 + lane) * 2);
                const float nr = a1k.x * sr - a1k.y * si + e.x, ni = a1k.x * si + a1k.y * sr + e.y; sr = nr; si = ni; }
#pragma unroll
            for (int kt = 0; kt < 4; ++kt) cf[kt] = *(const bf16x8*)(Cfrag + ((size_t)(g * 4 + kt) * 64 + lane) * 8);
            dd = *(const f32x4*)(dskip + g * 16 + 4 * fq);
        }
        f32x2 sv = {sr, si}; const f32x2 axx = {a.x, a.x}, ayn = {-a.y, a.y};
        const bf16_t* zrow = z + (tok0 + fr) * DM + g * 16 + 4 * fq;
        u32x2 ucur = *(const u32x2*)zrow;
#pragma nounroll
        for (int mt = 0; mt < 64; ++mt) {
            u32x2 unext = ucur; if (mt < 63) unext = *(const u32x2*)(zrow + (size_t)(mt + 1) * 16 * DM);
            const bf16x4 af = __builtin_bit_cast(bf16x4, ucur);
            f32x4 d[8];
#pragma unroll
            for (int t = 0; t < 8; ++t) d[t] = __builtin_amdgcn_mfma_f32_16x16x16bf16_1k(af, bf[t], (f32x4){0.f, 0.f, 0.f, 0.f}, 0, 0, 0);
#pragma unroll
            for (int tq = 0; tq < 4; ++tq)
#pragma unroll
                for (int j = 0; j < 4; ++j) *(LAS f32x2*)(BU + (4 * fq + j) * 528 + (16 * tq + fr) * 8) = (f32x2){d[tq][j], d[tq + 4][j]};
            asm volatile("s_waitcnt lgkmcnt(0)" ::: "memory");
#pragma unroll
            for (int j = 0; j < 16; ++j) {
                const f32x2 bu = *(const LAS f32x2*)(BU + j * 528 + lane * 8);
                sv = __builtin_elementwise_fma(ayn, __builtin_shufflevector(sv, sv, 1, 0), __builtin_elementwise_fma(axx, sv, bu));
                if (PASS == 2) *(LAS unsigned*)(SI + j * 272 + lane * 4) = cvt_pk_bf16(sv.x, sv.y);
            }
            if (PASS == 2) {
                asm volatile("s_waitcnt lgkmcnt(0)" ::: "memory");
                f32x4 acc = (f32x4){0.f, 0.f, 0.f, 0.f};
#pragma unroll
                for (int kt = 0; kt < 4; ++kt) { const bf16x8 sv = *(const LAS bf16x8*)(SI + fr * 272 + (32 * kt + 8 * fq) * 2);
                    acc = __builtin_amdgcn_mfma_f32_16x16x32_bf16(cf[kt], sv, acc, 0, 0, 0); }
                const size_t tok = tok0 + 16 * mt + fr;
                float o[4];
                const float uf[4] = {bflo(ucur.x), bfhi(ucur.x), bflo(ucur.y), bfhi(ucur.y)};
#pragma unroll
                for (int j = 0; j < 4; ++j) { const float y = acc[j] + dd[j] * uf[j]; o[j] = y * fsigmoid(1.5957691216057308f * (y + 0.044715f * y * y * y)); }
                u32x2 w; w.x = cvt_pk_bf16(o[0], o[1]); w.y = cvt_pk_bf16(o[2], o[3]);
                *(u32x2*)(ypre + tok * 512 + g * 16 + 4 * fq) = w;
            }
            asm volatile("" ::: "memory");
            ucur = unext;
        }
        if (PASS == 1) *(f32x2*)(E + ((size_t)((b * 32 + g) * 4 + r) * 64 + lane) * 2) = sv;
    }
}

__device__ __forceinline__ float bf2f(bf16_t v) { return __uint_as_float(((unsigned)v) << 16); }
template <int W> __device__ __forceinline__ void pool_round2(const bf16_t* zpa, bf16_t* mpa, const bf16_t* zpb, bf16_t* mpb, int t0) {
    float a[W - 1 + 16], c[W - 1 + 16];
#pragma unroll
    for (int i = 0; i < W - 1 + 16; ++i) { const int t = t0 - (W - 1) + i; a[i] = (t >= 0) ? bf2f(zpa[(size_t)t * DM]) : 0.f; c[i] = (t >= 0) ? bf2f(zpb[(size_t)t * DM]) : 0.f; }
    float sa = 0.f, sc = 0.f;
#pragma unroll
    for (int i = 0; i < W - 1; ++i) { sa += a[i]; sc += c[i]; }
#pragma unroll
    for (int j = 0; j < 16; ++j) {
        const int t = t0 + j; const float va = a[W - 1 + j], vc = c[W - 1 + j]; sa += va; sc += vc;
        const float inv = 1.0f / (float)((t + 1 < W) ? t + 1 : W);
        mpa[(size_t)t * DM] = f2bf(sa * inv - va); mpb[(size_t)t * DM] = f2bf(sc * inv - vc);
        sa -= a[j]; sc -= c[j];
    }
}
__device__ void pool_phase(const Params& P) {
    int tid = threadIdx.x; asm volatile("" : "+v"(tid));
    const int G = gridDim.x; unsigned char* ws = P.ws;
    const bf16_t* z = (const bf16_t*)(ws + WS_BIG + BIG_Z); bf16_t* mix = (bf16_t*)(ws + WS_BIG + BIG_MIX);
    const int ch = tid, gi = __builtin_amdgcn_readfirstlane(ch >> 7);
    for (int q = blockIdx.x; q < 2048; q += G) {
        const int t0 = (q & 255) * 16, b0 = (q >> 8) * 2;
        const bf16_t* zpa = z + (size_t)b0 * SEQ * DM + 512 + ch; bf16_t* mpa = mix + (size_t)b0 * SEQ * DM + 512 + ch;
        const bf16_t* zpb = zpa + (size_t)SEQ * DM; bf16_t* mpb = mpa + (size_t)SEQ * DM;
        if (gi == 0) pool_round2<2>(zpa, mpa, zpb, mpb, t0); else if (gi == 1) pool_round2<4>(zpa, mpa, zpb, mpb, t0); else if (gi == 2) pool_round2<8>(zpa, mpa, zpb, mpb, t0); else pool_round2<16>(zpa, mpa, zpb, mpb, t0);
    }
}

__device__ void final_norm(const Params& P, const float* ssp, const bf16_t* hi, const bf16_t* lo) {
    const int tid = threadIdx.x, lane = tid & 63, wave = tid >> 6, G = gridDim.x;
    float* out = P.out; const float* fn = P.in[25];
    f32x4 w[4];
#pragma unroll
    for (int q = 0; q < 4; ++q) w[q] = *(const f32x4*)(fn + q * 256 + lane * 4);
    for (int row = blockIdx.x * 8 + wave; row < TT; row += G * 8) {
        float ss = (lane < 16) ? ssp[(size_t)lane * TT + row] : 0.f;
        u32x2 hv[4], lv[4];
#pragma unroll
        for (int q = 0; q < 4; ++q) { hv[q] = *(const u32x2*)(hi + (size_t)row * DM + q * 256 + lane * 4); lv[q] = *(const u32x2*)(lo + (size_t)row * DM + q * 256 + lane * 4); }
#pragma unroll
        for (int o = 32; o >= 1; o >>= 1) ss += __shfl_xor(ss, o);
        const float r = 1.0f / sqrtf(ss * (1.0f / 1024.0f) + 1e-6f);
#pragma unroll
        for (int q = 0; q < 4; ++q) { const f32x4 v = {bflo(hv[q].x) + bflo(lv[q].x), bfhi(hv[q].x) + bfhi(lv[q].x), bflo(hv[q].y) + bflo(lv[q].y), bfhi(hv[q].y) + bfhi(lv[q].y)};
            *(f32x4*)(out + (size_t)row * DM + q * 256 + lane * 4) = v * r * w[q]; }
    }
}

__global__ void __launch_bounds__(NTHREADS, 2) mega_fwd(Params P) {
    extern __shared__ __attribute__((aligned(16))) unsigned char lds_raw[];
    LAS unsigned char* lds = (LAS unsigned char*)lds_raw;
    LAS float* rs = (LAS float*)(lds + STAGE_LDS);
    cg::grid_group grid = cg::this_grid();
#ifndef PHMASK
#define PHMASK 0xFFFF
#endif
#define HBC(l) ((bf16_t*)(wsb + (((l) & 1) ? WS_HB1 : WS_HB0)))
#define HBN(l) ((bf16_t*)(wsb + (((l) & 1) ? WS_HB0 : WS_HB1)))
#define SSPC(l) ((float*)(wsb + (((l) & 1) ? WS_SSP1 : WS_SSP0)))
#define SSPN(l) ((float*)(wsb + (((l) & 1) ? WS_SSP0 : WS_SSP1)))
#define WL(l) ((const bf16_t*)(wsb + WS_W) + (size_t)(l) * LW)
#define BIGP(T_, off) ((T_*)(wsb + WS_BIG + (off)))
#define LOP ((bf16_t*)(wsb + WS_LO))
    volatile LAS unsigned* xbst = (volatile LAS unsigned*)(lds + LDS_BYTES - 16);
    if (threadIdx.x < 4) xbst[threadIdx.x] = 0u;
    __syncthreads();
    const XcdBarrier xbar = xcd_barrier_post((unsigned*)(P.ws + WS_BAR), xbst);
    if (PHMASK & 1) prologue(P, lds);
    grid.sync();

    for (int ph = 0; ph < NLAYER * 11; ++ph) {
        const int l = ph / 11, k = ph - l * 11;
#ifndef REPK
#define REPK -1
#define REPN 1
#endif
        for (int rep = 0; rep < ((k == REPK) ? REPN : 1); ++rep) {
        int G = gridDim.x, cid = blockIdx.x; unsigned char* wsb = P.ws; asm volatile("" : "+s"(G), "+s"(cid), "+s"(wsb));
        switch (k) {
        case 0: if (PHMASK & 2) {
            pg8::RevOrder S; S.init(TT, 2 * FF, G, cid); build_rs(rs, SSPC(l));
            pg8::Gemm g{HBC(l), WL(l) + W_WI1, TT, 2 * FF, DM}; EpiSwiGLU E{BIGP(bf16_t, BIG_HID), rs}; pg8::gemm_phase(lds, g, S, E); } break;
        case 1: if (PHMASK & 4) {
            pg8::StaticOrder S; S.init(TT, DM, G, cid);
            pg8::Gemm g{BIGP(bf16_t, BIG_HID), WL(l) + W_WO1, TT, DM, FF}; EpiH<0> E{HBC(l), HBC(l), LOP, SSPC(l), 0.5f, nullptr, rs}; pg8::gemm_phase(lds, g, S, E); } break;
        case 2: if (PHMASK & 8) {
            pg8::RevOrder S; S.init(TT, DM, G, cid); build_rs(rs, SSPC(l));
            pg8::Gemm g{HBC(l), WL(l) + W_WIN, TT, DM, DM}; EpiZ E{BIGP(bf16_t, BIG_Z), rs}; pg8::gemm_phase(lds, g, S, E); } break;
        case 3: if (PHMASK & 16) {
            ssm_pass<1>(P, l, lds); pool_phase(P); conv_p(P, l); } break;
        case 4: if (PHMASK & 32) {
            ssm_pass<2>(P, l, lds); } break;
        case 5: if (PHMASK & 64) {
            pg8::StaticOrder S; S.init(TT, 512, G, cid);
            pg8::Gemm g{BIGP(bf16_t, BIG_YPRE), WL(l) + W_GLU, TT, 512, 512}; EpiGLU E{BIGP(bf16_t, BIG_YPRE), BIGP(bf16_t, BIG_MIX)}; pg8::gemm_phase(lds, g, S, E); } break;
        case 6: if (PHMASK & 128) {
            pg8::RevOrder S; S.init(TT, DM, G, cid);
            pg8::Gemm g{BIGP(bf16_t, BIG_MIX), WL(l) + W_OUT, TT, DM, DM}; EpiH<0> E{HBC(l), HBC(l), LOP, SSPC(l), 1.0f, nullptr, rs}; pg8::gemm_phase(lds, g, S, E); } break;
        case 7: if (PHMASK & 256) {
            pg8::StaticOrder S; S.init(TT, 2 * FF, G, cid); build_rs(rs, SSPC(l));
            pg8::Gemm g{HBC(l), WL(l) + W_WI2, TT, 2 * FF, DM}; EpiSwiGLU E{BIGP(bf16_t, BIG_HID), rs}; pg8::gemm_phase(lds, g, S, E); } break;
        case 8: if (PHMASK & 512) {
            pg8::RevOrder S; S.init(TT, DM, G, cid);
            pg8::Gemm g{BIGP(bf16_t, BIG_HID), WL(l) + W_WO2, TT, DM, FF}; EpiH<0> E{HBC(l), HBC(l), LOP, SSPC(l), 0.5f, nullptr, rs}; pg8::gemm_phase(lds, g, S, E); } break;
        case 9: if (PHMASK & 1024) {
            pg8::StaticOrder S; S.init(TT, DM, G, cid); build_rs(rs, SSPC(l));
            pg8::Gemm g{(const bf16_t*)(wsb + WS_PB), WL(l) + W_PLE, TT, DM, 256}; EpiProj E{BIGP(bf16_t, BIG_PROJ)}; pg8::gemm_phase(lds, g, S, E); } break;
        default: if (PHMASK & 1024) {
            pg8::StaticOrder S; S.init(TT, DM, G, cid);
            pg8::Gemm g{HBC(l), WL(l) + W_GATE, TT, DM, DM}; EpiH<1> E{HBC(l), HBN(l), LOP, SSPN(l), 1.0f, BIGP(bf16_t, BIG_PROJ), rs}; pg8::gemm_phase(lds, g, S, E); } break;
        }
        if (k != 9) xcd_barrier(xbar);
        }
    }
    if (PHMASK & 0x800) final_norm(P, (const float*)(P.ws + ((NLAYER & 1) ? WS_SSP1 : WS_SSP0)), (const bf16_t*)(P.ws + ((NLAYER & 1) ? WS_HB1 : WS_HB0)), (const bf16_t*)(P.ws + WS_LO));
}

extern "C" void kernel_launch(void* const* d_in, const int* in_sizes, int n_in, void* d_out, int out_size, void* d_ws, size_t ws_size, hipStream_t stream) {
    static int grid_blocks = 0;
    if (!grid_blocks) {
        int dev = 0, cus = 0, per_cu = 0;
        hipGetDevice(&dev);
        hipDeviceGetAttribute(&cus, hipDeviceAttributeMultiprocessorCount, dev);
        if (hipFuncSetAttribute((const void*)mega_fwd, hipFuncAttributeMaxDynamicSharedMemorySize, LDS_BYTES) != hipSuccess) fprintf(stderr, "hipFuncSetAttribute failed\n");
        if (hipOccupancyMaxActiveBlocksPerMultiprocessor(&per_cu, (const void*)mega_fwd, NTHREADS, LDS_BYTES) != hipSuccess || per_cu < 1) { per_cu = 1; (void)hipGetLastError(); }
        grid_blocks = cus * 1;
        if (ws_size < WS_END) fprintf(stderr, "workspace too small: %zu < %zu\n", ws_size, (size_t)WS_END);
    }
    Params p{};
    for (int i = 0; i < 26; ++i) p.in[i] = (const float*)d_in[i];
    p.out = (float*)d_out; p.ws = (unsigned char*)d_ws;
    if (hipMemsetAsync((char*)d_ws + WS_BAR, 0, 16384, stream) != hipSuccess) fprintf(stderr, "memset of barrier words failed\n");
    void* args[] = {&p};
    hipError_t e = hipLaunchCooperativeKernel((void*)mega_fwd, dim3(grid_blocks), dim3(NTHREADS), args, LDS_BYTES, stream);
    if (e != hipSuccess) fprintf(stderr, "cooperative launch failed: %s (grid %d)\n", hipGetErrorString(e), grid_blocks);
}
```

```cpp
#include <hip/hip_runtime.h>
#include <hip/hip_cooperative_groups.h>
#include <cstdio>
namespace cg = cooperative_groups;

#define LAS __attribute__((address_space(3)))
typedef unsigned short bf16_t;
typedef short bf16x8 __attribute__((ext_vector_type(8)));
typedef float f32x4 __attribute__((ext_vector_type(4)));
typedef float f32x2 __attribute__((ext_vector_type(2)));
typedef unsigned u32x4 __attribute__((ext_vector_type(4)));
typedef unsigned u32x2 __attribute__((ext_vector_type(2)));

constexpr int TT = 65536;
constexpr int SEQ = 4096;
constexpr int DM = 1024;
constexpr int FF = 2816;
constexpr int NLAYER = 4;
constexpr int NTHREADS = 512;
constexpr int STAGE_LDS = 131072;
constexpr int RS_LDS = 24576;
constexpr int LDS_BYTES = STAGE_LDS + RS_LDS;

constexpr size_t WS_HB0 = 0;
constexpr size_t WS_HB1 = 134217728ull;
constexpr size_t WS_BIG = 268435456ull;
constexpr size_t BIG_HID = 0, BIG_Z = 0, BIG_PROJ = 0, BIG_MIX = 134217728ull, BIG_YPRE = 268435456ull, BIG_E = 335544320ull;
constexpr size_t BIG_SIZE = 369098752ull;
constexpr size_t WS_PB = WS_BIG + BIG_SIZE;
constexpr size_t WS_W = WS_PB + 33554432ull;
constexpr size_t LW = 20971520ull;
constexpr size_t W_WI1 = 0, W_WO1 = 5767168, W_WIN = 8650752, W_GLU = 9699328, W_OUT = 9961472, W_WI2 = 11010048, W_WO2 = 16777216, W_GATE = 19660800, W_PLE = 20709376;
constexpr size_t WS_SSP0 = WS_W + LW * 2 * NLAYER;
constexpr size_t WS_SSP1 = WS_SSP0 + 4194304ull;
constexpr size_t WS_SSM = WS_SSP1 + 4194304ull;
constexpr size_t SSM_LAMB = 0, SSM_LAMB1K = 16384, SSM_BFRAG = 32768, SSM_CFRAG = 32768 + 131072, SSM_LBYTES = 32768 + 131072 + 131072;
constexpr size_t WS_BAR = WS_SSM + SSM_LBYTES * NLAYER;
constexpr size_t WS_LO = WS_BAR + 16384;
constexpr size_t WS_END = WS_LO + 134217728ull;

struct Params { const float* in[26]; float* out; unsigned char* ws; };
#define GAS __attribute__((address_space(1)))
#define GP(T_, p) ((GAS T_*)(p))

typedef __bf16 bfx2_t __attribute__((ext_vector_type(2)));
__device__ __forceinline__ unsigned cvt_pk_bf16(float lo, float hi) { const f32x2 v = {lo, hi}; return __builtin_bit_cast(unsigned, __builtin_convertvector(v, bfx2_t)); }
__device__ __forceinline__ bf16_t f2bf(float f) { unsigned u = __float_as_uint(f); u += 0x7FFFu + ((u >> 16) & 1u); return (bf16_t)(u >> 16); }
__device__ __forceinline__ float bflo(unsigned w) { return __uint_as_float(w << 16); }
__device__ __forceinline__ float bfhi(unsigned w) { return __uint_as_float(w & 0xffff0000u); }
__device__ __forceinline__ unsigned lo_pack4(float a, float b, float c, float d) { int p = __builtin_amdgcn_cvt_pk_fp8_f32(a * 512.0f, b * 512.0f, 0, false); return (unsigned)__builtin_amdgcn_cvt_pk_fp8_f32(c * 512.0f, d * 512.0f, p, true); }
__device__ __forceinline__ f32x4 lo_unpack4(unsigned w) { const f32x2 a = __builtin_amdgcn_cvt_pk_f32_fp8((int)w, false), b = __builtin_amdgcn_cvt_pk_f32_fp8((int)w, true); return (f32x4){a.x, a.y, b.x, b.y} * (1.0f / 512.0f); }
__device__ __forceinline__ float fsigmoid(float x) { return __builtin_amdgcn_rcpf(1.0f + __builtin_amdgcn_exp2f(-1.4426950408889634f * x)); }


#define XB_TMO      128
#define XB_XCNT(j)  (256  + 64 * (j))
#define XB_XSUB(j)  (1280 + 64 * (j))
#define XB_XGEN(j)  (2304 + 64 * (j))
#define XB_TOP      3328
#define XB_TOPGEN   3392
#define XCD_BAR_WORDS 3456
#define XB_SPIN_CAP (1u << 18)
__device__ __forceinline__ unsigned xb_ld(unsigned* p)              { return __hip_atomic_load(p, __ATOMIC_RELAXED, __HIP_MEMORY_SCOPE_AGENT); }
__device__ __forceinline__ unsigned xb_add(unsigned* p, unsigned v) { return __hip_atomic_fetch_add(p, v, __ATOMIC_RELAXED, __HIP_MEMORY_SCOPE_AGENT); }
__device__ __forceinline__ unsigned xb_xcc_id() { return (unsigned)__builtin_amdgcn_s_getreg((3 << 11) | 20) & 0xFu; }
#define XB_SPIN(cond, bar) do { unsigned _sp = 0; while (cond) { __builtin_amdgcn_s_sleep(1); \
    if ((++_sp & 255u) == 0u) { if (xb_ld(&(bar)[XB_TMO])) break; if (_sp > XB_SPIN_CAP) { atomicAdd(&(bar)[XB_TMO], 1u); break; } } } } while (0)
struct XcdBarrier { unsigned* bar; unsigned x; volatile LAS unsigned* st; };
__device__ __forceinline__ XcdBarrier xcd_barrier_post(unsigned* bar, volatile LAS unsigned* st) {
    XcdBarrier b; b.bar = bar; b.x = xb_xcc_id(); b.st = st;
    if (threadIdx.x == 0) (void)xb_add(&bar[XB_XCNT(b.x)], 1u);
    return b;
}
__device__ __forceinline__ void xcd_barrier_complete(unsigned* bar, unsigned x, unsigned& nloc, unsigned& nx) {
    const unsigned G = gridDim.x * gridDim.y * gridDim.z;
    unsigned sum, cnt, mine, sp = 0u;
    for (;;) {
        sum = 0u; cnt = 0u; mine = 0u;
#pragma unroll
        for (unsigned j = 0; j < 16; ++j) { const unsigned c = xb_ld(&bar[XB_XCNT(j)]); sum += c; cnt += (c > 0u) ? 1u : 0u; mine = (j == x) ? c : mine; }
        if (sum == G) break;
        __builtin_amdgcn_s_sleep(1);
        if ((++sp & 255u) == 0u) { if (xb_ld(&bar[XB_TMO])) break; if (sp > XB_SPIN_CAP) { atomicAdd(&bar[XB_TMO], 1u); break; } }
    }
    nloc = mine > 0u ? mine : 1u; nx = cnt > 0u ? cnt : 1u;
}
__device__ __forceinline__ void xcd_barrier(const XcdBarrier& b) {
    asm volatile("s_waitcnt vmcnt(0)" ::: "memory");
    __syncthreads();
    if (threadIdx.x == 0) {
        unsigned* bar = b.bar;
        __builtin_amdgcn_s_waitcnt(0);
        unsigned nloc = b.st[0], nx = b.st[1];
        if (nloc == 0u) { xcd_barrier_complete(bar, b.x, nloc, nx); b.st[0] = nloc; b.st[1] = nx; }
        const unsigned old = xb_add(&bar[XB_XSUB(b.x)], 1u);
        const unsigned gen = old / nloc;
        if (old + 1u == (gen + 1u) * nloc) {
            __builtin_amdgcn_fence(__ATOMIC_RELEASE, "agent");
            asm volatile("s_waitcnt vmcnt(0)" ::: "memory");
            const unsigned og = xb_add(&bar[XB_TOP], 1u);
            const unsigned tg = og / nx;
            if (og + 1u == (tg + 1u) * nx) xb_add(&bar[XB_TOPGEN], 1u);
            else XB_SPIN(xb_ld(&bar[XB_TOPGEN]) == tg, bar);
            __builtin_amdgcn_fence(__ATOMIC_ACQUIRE, "agent");
            xb_add(&bar[XB_XGEN(b.x)], 1u);
            asm volatile("s_waitcnt vmcnt(0)" ::: "memory");
        } else {
            XB_SPIN(xb_ld(&bar[XB_XGEN(b.x)]) == gen, bar);
            __builtin_amdgcn_fence(__ATOMIC_ACQUIRE, "agent");
            asm volatile("s_waitcnt vmcnt(0)" ::: "memory");
        }
    }
    __syncthreads();
}

namespace pg8 {
constexpr int BM = 256, BK = 64, HALF = 128, HTB = HALF * BK * 2, NXCD = 8, WGM = 8;
__device__ __forceinline__ int lds_byte(int r, int c) { const int st = (r >> 4) * 2 + (c >> 5), rr = r & 15, cc = c & 31, ob = rr * 64 + cc * 2; return st * 1024 + (ob ^ (((ob >> 9) & 1) << 5)); }
__device__ __forceinline__ void stage_rc(int b, int& R, int& C) { const int st = b / 1024, sb = b % 1024, swz = sb ^ (((sb >> 9) & 1) << 5); R = (st >> 1) * 16 + swz / 64; C = (st & 1) * 32 + (swz % 64) / 2; }
__device__ __forceinline__ int perm32(int rho) { const int n = rho >> 4, i = rho & 15; return 8 * (i >> 2) + 4 * n + (i & 3); }
struct Unit { int pm, pn; };
struct Gemm { const bf16_t* A; const bf16_t* Bt; int M, N, K; };
struct StaticOrder {
    int nM, nN, nwg, G, c;
    __device__ void init(int M, int N, int G_, int c_) { nM = M / BM; nN = N / BM; nwg = nM * nN; G = G_; c = c_; }
    __device__ bool next(int i, Unit& u) const {
        const long L = (long)i * G + c; if (L >= nwg) return false;
        int wgid = (int)L; { const int q = nwg / NXCD, r = nwg % NXCD, xcd = wgid % NXCD, off = wgid / NXCD; wgid = (xcd < r ? xcd * (q + 1) : r * (q + 1) + (xcd - r) * q) + off; }
        const int nig = WGM * nN, gid = wgid / nig, fm = gid * WGM, gsz = (nM - fm) < WGM ? (nM - fm) : WGM;
        u.pm = fm + ((wgid % nig) % gsz); u.pn = (wgid % nig) / gsz; return true;
    }
};
struct RevOrder : StaticOrder { __device__ bool next(int i, Unit& u) const { const int nr = (nwg + G - 1) / G; if (i < 0 || i >= nr) return false; return StaticOrder::next(nr - 1 - i, u); } };
template <class Epi, class Ord>
__device__ __forceinline__ void gemm_phase(LAS unsigned char* lds, const Gemm g, const Ord& S, const Epi& E) {
    int tid = threadIdx.x; asm volatile("" : "+v"(tid));
    const int wid = __builtin_amdgcn_readfirstlane(tid >> 6), lane = tid & 63, wr = wid >> 2, wc = wid & 3, fr = lane & 15, fq = lane >> 4;
    int K = g.K; asm volatile("" : "+s"(K));
    const int nt = K / BK;
    unsigned voffA[2], voffB[2];
#pragma unroll
    for (int i = 0; i < 2; ++i) { int R, C; stage_rc(tid * 16 + i * 8192, R, C); const int Rb = (R & ~31) + perm32(R & 31);
        voffA[i] = (unsigned)(R * K + C) * 2u; voffB[i] = (unsigned)(Rb * K + C) * 2u; }
    const size_t kstep = (size_t)(BK * 2);
    const size_t hstep = (size_t)HALF * K * 2;
    const size_t tstep = 2 * hstep;
    const unsigned ldsw = (unsigned)wid * 1024u;
    const int aoff = lds_byte(wr * 64 + fr, fq * 8), boff = lds_byte(wc * 32 + fr, fq * 8);
#define PG8_SA(b, h) (((b) * 2 + (h)) * HTB)
#define PG8_SB(b, h) ((4 + (b) * 2 + (h)) * HTB)
#define PG8_STAGE(bufoff, gbase, voff) do { const char* _gb = (const char*)(gbase); asm volatile("" : "+s"(_gb)); _Pragma("unroll") for (int _i = 0; _i < 2; ++_i) { unsigned _vo = (voff)[_i]; asm volatile("" : "+v"(_vo)); \
        __builtin_amdgcn_global_load_lds((const GAS unsigned*)(_gb + _vo), (LAS unsigned*)(lds + (bufoff) + ldsw + _i * 8192), 16, 0, 0); } } while (0)
#define PG8_LDA(dst, b, h) do { _Pragma("unroll") for (int m = 0; m < 4; ++m) _Pragma("unroll") for (int k = 0; k < 2; ++k) dst[m][k] = *(const LAS bf16x8*)(lds + PG8_SA(b, h) + aoff + m * 2048 + k * 1024); } while (0)
#define PG8_LDB(dst, b, h) do { _Pragma("unroll") for (int n = 0; n < 2; ++n) _Pragma("unroll") for (int k = 0; k < 2; ++k) dst[n][k] = *(const LAS bf16x8*)(lds + PG8_SB(b, h) + boff + n * 2048 + k * 1024); } while (0)
#define PG8_MMA(ai, bj, At, Bt) do { __builtin_amdgcn_s_setprio(1); _Pragma("unroll") for (int m = 0; m < 4; ++m) _Pragma("unroll") for (int n = 0; n < 2; ++n) _Pragma("unroll") for (int k = 0; k < 2; ++k) \
        acc[ai][bj][m][n] = __builtin_amdgcn_mfma_f32_16x16x32_bf16(Bt[n][k], At[m][k], acc[ai][bj][m][n], 0, 0, 0); __builtin_amdgcn_s_setprio(0); } while (0)
#define PG8_WAIT_V(n) asm volatile("s_waitcnt vmcnt(" #n ")" ::: "memory")
#define PG8_WAIT_L(n) asm volatile("s_waitcnt lgkmcnt(" #n ")" ::: "memory")
#define PG8_BAR __builtin_amdgcn_s_barrier()
#define PG8_SCHED __builtin_amdgcn_sched_barrier(0)
    Unit cur, nxt; int ui = 0;
    if (!S.next(0, cur)) return;
    f32x4 acc[2][2][4][2];
#pragma unroll
    for (int a = 0; a < 2; ++a)
#pragma unroll
        for (int b = 0; b < 2; ++b)
#pragma unroll
            for (int m = 0; m < 4; ++m)
#pragma unroll
                for (int n = 0; n < 2; ++n) acc[a][b][m][n] = (f32x4){0.f, 0.f, 0.f, 0.f};
    bf16x8 At[4][2], B0[2][2], B1[2][2];
    const char* cA = (const char*)g.A + (size_t)cur.pm * tstep; const char* cB = (const char*)g.Bt + (size_t)cur.pn * tstep;
    PG8_STAGE(PG8_SB(0, 0), cB, voffB); PG8_STAGE(PG8_SA(0, 0), cA, voffA); PG8_STAGE(PG8_SB(0, 1), cB + hstep, voffB); PG8_STAGE(PG8_SA(0, 1), cA + hstep, voffA);
    if (wr == 1) PG8_BAR;
    PG8_WAIT_V(4); PG8_BAR;
    PG8_STAGE(PG8_SB(1, 0), cB + kstep, voffB); PG8_STAGE(PG8_SA(1, 0), cA + kstep, voffA); PG8_STAGE(PG8_SB(1, 1), cB + hstep + kstep, voffB);
    PG8_WAIT_V(6); PG8_BAR;
    for (;;) {
        const bool has_next = S.next(ui + 1, nxt);
        const char* nA = has_next ? (const char*)g.A + (size_t)nxt.pm * tstep : cA; const char* nB = has_next ? (const char*)g.Bt + (size_t)nxt.pn * tstep : cB;
#pragma nounroll
        for (int t = 0; t < nt; t += 2) {
            const bool last = (t == nt - 2);
            const char* a1 = cA + (size_t)(t + 1) * kstep;
            const char* a2 = last ? nA : cA + (size_t)(t + 2) * kstep; const char* b2 = last ? nB : cB + (size_t)(t + 2) * kstep;
            const char* a3 = a2 + kstep; const char* b3 = b2 + kstep;
            PG8_LDB(B0, 0, 0); PG8_SCHED; PG8_LDA(At, 0, 0); PG8_STAGE(PG8_SA(1, 1), a1 + hstep, voffA);
            PG8_WAIT_L(8); PG8_BAR; PG8_WAIT_L(0); PG8_MMA(0, 0, At, B0); PG8_BAR; PG8_SCHED;
            PG8_LDB(B1, 0, 1); PG8_STAGE(PG8_SB(0, 0), b2, voffB);
            PG8_BAR; PG8_WAIT_L(0); PG8_MMA(0, 1, At, B1); PG8_BAR;
            PG8_LDA(At, 0, 1); PG8_STAGE(PG8_SA(0, 0), a2, voffA);
            PG8_BAR; PG8_WAIT_L(0); PG8_MMA(1, 0, At, B0); PG8_BAR; PG8_SCHED;
            PG8_STAGE(PG8_SB(0, 1), b2 + hstep, voffB);
            PG8_WAIT_V(6); PG8_BAR; PG8_MMA(1, 1, At, B1); PG8_BAR;
            PG8_LDB(B0, 1, 0); PG8_SCHED; PG8_LDA(At, 1, 0); PG8_STAGE(PG8_SA(0, 1), a2 + hstep, voffA);
            PG8_WAIT_L(8); PG8_BAR; PG8_WAIT_L(0); PG8_MMA(0, 0, At, B0); PG8_BAR; PG8_SCHED;
            PG8_LDB(B1, 1, 1); PG8_STAGE(PG8_SB(1, 0), b3, voffB);
            PG8_BAR; PG8_WAIT_L(0); PG8_MMA(0, 1, At, B1); PG8_BAR;
            PG8_LDA(At, 1, 1); PG8_STAGE(PG8_SA(1, 0), a3, voffA);
            PG8_BAR; PG8_WAIT_L(0); PG8_MMA(1, 0, At, B0); PG8_BAR; PG8_SCHED;
            PG8_STAGE(PG8_SB(1, 1), b3 + hstep, voffB);
            PG8_WAIT_V(6); PG8_BAR; PG8_MMA(1, 1, At, B1); PG8_BAR;
        }
        E(acc, cur, ui, wr, wc, fr, fq);
        if (!has_next) break;
#pragma unroll
        for (int a = 0; a < 2; ++a)
#pragma unroll
            for (int b = 0; b < 2; ++b)
#pragma unroll
                for (int m = 0; m < 4; ++m)
#pragma unroll
                    for (int n = 0; n < 2; ++n) acc[a][b][m][n] = (f32x4){0.f, 0.f, 0.f, 0.f};
        cur = nxt; cA = nA; cB = nB; ++ui;
    }
    PG8_WAIT_V(0);
    if (wr == 0) PG8_BAR;
    PG8_BAR;
#undef PG8_SA
#undef PG8_SB
#undef PG8_STAGE
#undef PG8_LDA
#undef PG8_LDB
#undef PG8_MMA
#undef PG8_WAIT_V
#undef PG8_WAIT_L
#undef PG8_BAR
#undef PG8_SCHED
}
}
using pg8::Unit;
typedef f32x4 AccT[2][2][4][2];

struct EpiSwiGLU {
    bf16_t* O; const LAS float* rs;
    __device__ __forceinline__ void operator()(const AccT& acc, const Unit& u, int ui, int wr, int wc, int fr, int fq) const {
        const int col = u.pn * 128 + wc * 32 + 8 * fq;
#pragma unroll
        for (int ai = 0; ai < 2; ++ai)
#pragma unroll
            for (int m = 0; m < 4; ++m) {
                const int rl = ai * 128 + wr * 64 + m * 16 + fr; const float r = rs[((u.pm >> 3) & 3) * 256 + rl];
                const float nr = -1.4426950408889634f * r, r2 = r * r;
                unsigned w[4];
#pragma unroll
                for (int n = 0; n < 2; ++n)
#pragma unroll
                    for (int hlf = 0; hlf < 2; ++hlf) {
                        const f32x2 a = {acc[ai][0][m][n][2 * hlf], acc[ai][0][m][n][2 * hlf + 1]}, b = {acc[ai][1][m][n][2 * hlf], acc[ai][1][m][n][2 * hlf + 1]};
                        const f32x2 t = a * nr;
                        f32x2 d; d.x = __builtin_amdgcn_exp2f(t.x); d.y = __builtin_amdgcn_exp2f(t.y); d = d + 1.0f;
                        f32x2 q; q.x = __builtin_amdgcn_rcpf(d.x); q.y = __builtin_amdgcn_rcpf(d.y);
                        const f32x2 o = ((a * b) * r2) * q;
                        w[n * 2 + hlf] = cvt_pk_bf16(o.x, o.y);
                    }
                u32x4 wv; wv.x = w[0]; wv.y = w[1]; wv.z = w[2]; wv.w = w[3];
                *GP(u32x4, O + (size_t)(u.pm * 256 + rl) * FF + col) = wv;
            }
    }
};
template <int MODE> struct EpiH {
    const bf16_t* hin; bf16_t* hout; unsigned char* lo; float* ssp; float alpha; const bf16_t* proj; const LAS float* rs;
    template <int NM> __device__ __forceinline__ void round(const AccT& acc, const Unit& u, int ai, int m0, int wr, int wc, int fr, int fq) const {
        u32x4 hv[NM][2], pv[NM][2]; u32x2 lv[NM][2];
#pragma unroll
        for (int mm = 0; mm < NM; ++mm) {
            const int rl = ai * 128 + wr * 64 + (m0 + mm) * 16 + fr;
            const size_t off = (size_t)(u.pm * 256 + rl) * DM + u.pn * 256 + wc * 32 + 8 * fq;
#pragma unroll
            for (int bj = 0; bj < 2; ++bj) {
                hv[mm][bj] = *GP(const u32x4, hin + off + bj * 128); lv[mm][bj] = *GP(const u32x2, lo + off + bj * 128);
                if (MODE == 1) pv[mm][bj] = *GP(const u32x4, proj + off + bj * 128);
            }
        }
#pragma unroll
        for (int mm = 0; mm < NM; ++mm) {
            const int m = m0 + mm;
            const int rl = ai * 128 + wr * 64 + m * 16 + fr; const int row = u.pm * 256 + rl;
            const size_t off = (size_t)row * DM + u.pn * 256 + wc * 32 + 8 * fq;
            float r = 1.f; if (MODE == 1) r = rs[((u.pm >> 3) & 3) * 256 + rl];
            float ss = 0.f;
#pragma unroll
            for (int bj = 0; bj < 2; ++bj) {
                f32x4 d0, d1;
                if (MODE == 0) { d0 = acc[ai][bj][m][0] * alpha; d1 = acc[ai][bj][m][1] * alpha; }
                else {
                    const u32x4 p = pv[mm][bj];
                    const f32x4 a0 = acc[ai][bj][m][0] * r, a1 = acc[ai][bj][m][1] * r;
                    d0 = (f32x4){fsigmoid(a0[0]) * bflo(p.x), fsigmoid(a0[1]) * bfhi(p.x), fsigmoid(a0[2]) * bflo(p.y), fsigmoid(a0[3]) * bfhi(p.y)};
                    d1 = (f32x4){fsigmoid(a1[0]) * bflo(p.z), fsigmoid(a1[1]) * bfhi(p.z), fsigmoid(a1[2]) * bflo(p.w), fsigmoid(a1[3]) * bfhi(p.w)};
                }
                const u32x4 H = hv[mm][bj]; const u32x2 L = lv[mm][bj];
                const f32x4 o0 = ((f32x4){bflo(H.x), bfhi(H.x), bflo(H.y), bfhi(H.y)} + lo_unpack4(L.x)) + d0;
                const f32x4 o1 = ((f32x4){bflo(H.z), bfhi(H.z), bflo(H.w), bfhi(H.w)} + lo_unpack4(L.y)) + d1;
                u32x4 w; w.x = cvt_pk_bf16(o0[0], o0[1]); w.y = cvt_pk_bf16(o0[2], o0[3]); w.z = cvt_pk_bf16(o1[0], o1[1]); w.w = cvt_pk_bf16(o1[2], o1[3]);
                u32x2 wl; wl.x = lo_pack4(o0[0] - bflo(w.x), o0[1] - bfhi(w.x), o0[2] - bflo(w.y), o0[3] - bfhi(w.y));
                wl.y = lo_pack4(o1[0] - bflo(w.z), o1[1] - bfhi(w.z), o1[2] - bflo(w.w), o1[3] - bfhi(w.w));
                *GP(u32x4, hout + off + bj * 128) = w; *GP(u32x2, lo + off + bj * 128) = wl;
                ss += (o0[0] * o0[0] + o0[1] * o0[1]) + (o0[2] * o0[2] + o0[3] * o0[3]) + (o1[0] * o1[0] + o1[1] * o1[1]) + (o1[2] * o1[2] + o1[3] * o1[3]);
            }
            ss += __shfl_xor(ss, 16); ss += __shfl_xor(ss, 32);
            if (fq == 0) *GP(float, ssp + (size_t)(u.pn * 4 + wc) * TT + row) = ss;
        }
        asm volatile("" ::: "memory");
    }
    __device__ __forceinline__ void operator()(const AccT& acc, const Unit& u, int ui, int wr, int wc, int fr, int fq) const {
        if (MODE == 0) { round<4>(acc, u, 0, 0, wr, wc, fr, fq); round<4>(acc, u, 1, 0, wr, wc, fr, fq); }
        else { round<2>(acc, u, 0, 0, wr, wc, fr, fq); round<2>(acc, u, 0, 2, wr, wc, fr, fq); round<2>(acc, u, 1, 0, wr, wc, fr, fq); round<2>(acc, u, 1, 2, wr, wc, fr, fq); }
    }
};
struct EpiZ {
    bf16_t* Z; const LAS float* rs;
    __device__ __forceinline__ void operator()(const AccT& acc, const Unit& u, int ui, int wr, int wc, int fr, int fq) const {
#pragma unroll
        for (int ai = 0; ai < 2; ++ai)
#pragma unroll
            for (int m = 0; m < 4; ++m) {
                const int rl = ai * 128 + wr * 64 + m * 16 + fr; const float r = rs[((u.pm >> 3) & 3) * 256 + rl];
                bf16_t* p = Z + (size_t)(u.pm * 256 + rl) * DM + u.pn * 256 + wc * 32 + 8 * fq;
#pragma unroll
                for (int bj = 0; bj < 2; ++bj) { const f32x4 a0 = acc[ai][bj][m][0] * r, a1 = acc[ai][bj][m][1] * r;
                    u32x4 w; w.x = cvt_pk_bf16(a0[0], a0[1]); w.y = cvt_pk_bf16(a0[2], a0[3]); w.z = cvt_pk_bf16(a1[0], a1[1]); w.w = cvt_pk_bf16(a1[2], a1[3]);
                    *GP(u32x4, p + bj * 128) = w; }
            }
    }
};
struct EpiGLU {
    const bf16_t* Y; bf16_t* MIX;
    __device__ __forceinline__ void operator()(const AccT& acc, const Unit& u, int ui, int wr, int wc, int fr, int fq) const {
#pragma unroll
        for (int ai = 0; ai < 2; ++ai) {
            u32x4 yv[4][2];
#pragma unroll
            for (int m = 0; m < 4; ++m)
#pragma unroll
                for (int bj = 0; bj < 2; ++bj) yv[m][bj] = *GP(const u32x4, Y + (size_t)(u.pm * 256 + ai * 128 + wr * 64 + m * 16 + fr) * 512 + u.pn * 256 + bj * 128 + wc * 32 + 8 * fq);
#pragma unroll
            for (int m = 0; m < 4; ++m) {
                const int row = u.pm * 256 + ai * 128 + wr * 64 + m * 16 + fr;
#pragma unroll
                for (int bj = 0; bj < 2; ++bj) {
                    const int col = u.pn * 256 + bj * 128 + wc * 32 + 8 * fq;
                    const u32x4 y = yv[m][bj];
                    const f32x4 a0 = acc[ai][bj][m][0], a1 = acc[ai][bj][m][1];
                    u32x4 w;
                    w.x = cvt_pk_bf16(bflo(y.x) * fsigmoid(a0[0]), bfhi(y.x) * fsigmoid(a0[1]));
                    w.y = cvt_pk_bf16(bflo(y.y) * fsigmoid(a0[2]), bfhi(y.y) * fsigmoid(a0[3]));
                    w.z = cvt_pk_bf16(bflo(y.z) * fsigmoid(a1[0]), bfhi(y.z) * fsigmoid(a1[1]));
                    w.w = cvt_pk_bf16(bflo(y.w) * fsigmoid(a1[2]), bfhi(y.w) * fsigmoid(a1[3]));
                    *GP(u32x4, MIX + (size_t)row * DM + col) = w;
                }
            }
            asm volatile("" ::: "memory");
        }
    }
};
struct EpiProj {
    bf16_t* O;
    __device__ __forceinline__ void operator()(const AccT& acc, const Unit& u, int ui, int wr, int wc, int fr, int fq) const {
#pragma unroll
        for (int ai = 0; ai < 2; ++ai)
#pragma unroll
            for (int m = 0; m < 4; ++m) {
                const int row = u.pm * 256 + ai * 128 + wr * 64 + m * 16 + fr;
                bf16_t* p = O + (size_t)row * DM + u.pn * 256 + wc * 32 + 8 * fq;
#pragma unroll
                for (int bj = 0; bj < 2; ++bj) {
                    const f32x4 a0 = acc[ai][bj][m][0], a1 = acc[ai][bj][m][1];
                    u32x4 w; w.x = cvt_pk_bf16(a0[0], a0[1]); w.y = cvt_pk_bf16(a0[2], a0[3]); w.z = cvt_pk_bf16(a1[0], a1[1]); w.w = cvt_pk_bf16(a1[2], a1[3]);
                    *GP(u32x4, p + bj * 128) = w;
                }
            }
    }
};

__device__ __forceinline__ void build_rs(LAS float* rs, const float* ssp) {
    int tid = threadIdx.x, c = blockIdx.x; asm volatile("" : "+v"(tid), "+s"(c));
#pragma unroll
    for (int e2 = 0; e2 < 2; ++e2) {
        const int e = tid + e2 * NTHREADS, slot = e >> 8, t = e & 255;
        const int pm = 32 * (c & 7) + 8 * slot + ((c >> 3) & 7); const int row = pm * 256 + t; float sacc = 0.f;
#pragma unroll
        for (int q = 0; q < 16; ++q) sacc += *GP(const float, ssp + (size_t)q * TT + row);
        rs[slot * 256 + t] = 1.0f / sqrtf(sacc * (1.0f / 1024.0f) + 1e-6f);
    }
    __syncthreads();
}

__device__ __forceinline__ void convT_tile(const float* src, int ldsrc, const float* sc, bf16_t* dst, int dstld, int k0, int n0, int swiglu, LAS float* t) {
    const int tid = threadIdx.x;
    { const int r = tid >> 6, c4 = (tid & 63) * 4;
      int ncol = n0 + c4; if (swiglu) { const int blk = n0 >> 8; ncol = (c4 < 128) ? (128 * blk + c4) : (FF + 128 * blk + (c4 - 128)); }
      f32x4 v[8]; float sv[8];
#pragma unroll
      for (int i = 0; i < 8; ++i) { const int rr = r + 8 * i; v[i] = *(const f32x4*)(src + (size_t)(k0 + rr) * ldsrc + ncol); sv[i] = sc ? sc[k0 + rr] : 1.0f; }
#pragma unroll
      for (int i = 0; i < 8; ++i) { const int rr = r + 8 * i; t[rr * 257 + c4 + 0] = v[i][0] * sv[i]; t[rr * 257 + c4 + 1] = v[i][1] * sv[i]; t[rr * 257 + c4 + 2] = v[i][2] * sv[i]; t[rr * 257 + c4 + 3] = v[i][3] * sv[i]; } }
    __syncthreads();
    { const int nn = tid >> 1, kh = (tid & 1) * 32;
#pragma unroll
      for (int q = 0; q < 4; ++q) { float v[8];
#pragma unroll
          for (int j = 0; j < 8; ++j) v[j] = t[(kh + q * 8 + j) * 257 + nn];
          u32x4 w; w.x = cvt_pk_bf16(v[0], v[1]); w.y = cvt_pk_bf16(v[2], v[3]); w.z = cvt_pk_bf16(v[4], v[5]); w.w = cvt_pk_bf16(v[6], v[7]);
          *(u32x4*)(dst + (size_t)(n0 + nn) * dstld + k0 + kh + q * 8) = w; } }
    __syncthreads();
}
__device__ __forceinline__ void convT(const float* src, int ldsrc, const float* sc, bf16_t* dst, int dstld, int Krows, int Ncols, int swiglu, LAS float* t, int& base) {
    const int G = gridDim.x, nkt = Krows / 64, ntiles = nkt * (Ncols / 256);
    int first = ((int)blockIdx.x - (base % G) + G) % G;
    for (int idx = first; idx < ntiles; idx += G) {
        const int kt = idx % nkt, ntile = idx / nkt;
        convT_tile(src, ldsrc, sc, dst, dstld, kt * 64, ntile * 256, swiglu, t);
    }
    base += ntiles;
}
__device__ __forceinline__ void conv_poolout(const float* pw, const float* pscale, const float* wout, bf16_t* dst, LAS float* t, int& base) {
    const int G = gridDim.x, tid = threadIdx.x, ntiles = 8 * 16;
    int first = ((int)blockIdx.x - (base % G) + G) % G;
    for (int idx = first; idx < ntiles; idx += G) {
        const int k0 = (idx & 7) * 64, n0 = (idx >> 3) * 64;
        const int tn = tid & 63, tk = tid >> 6; const int kb = k0 + tk * 8; const int gi = kb >> 7, kk0 = kb & 127;
        float a[8];
#pragma unroll
        for (int i = 0; i < 8; ++i) a[i] = 0.f;
        const float* pwg = pw + (size_t)gi * 128 * 128 + (size_t)kk0 * 128;
        for (int m = 0; m < 128; ++m) {
            const float w = wout[(size_t)(512 + gi * 128 + m) * DM + n0 + tn] * pscale[gi * 128 + m];
#pragma unroll
            for (int i = 0; i < 8; ++i) a[i] += pwg[i * 128 + m] * w;
        }
#pragma unroll
        for (int i = 0; i < 8; ++i) t[(tk * 8 + i) * 65 + tn] = a[i];
        __syncthreads();
        { const int nn = tid >> 3, k8 = (tid & 7) * 8; float v[8];
#pragma unroll
          for (int j = 0; j < 8; ++j) v[j] = t[(k8 + j) * 65 + nn];
          u32x4 w; w.x = cvt_pk_bf16(v[0], v[1]); w.y = cvt_pk_bf16(v[2], v[3]); w.z = cvt_pk_bf16(v[4], v[5]); w.w = cvt_pk_bf16(v[6], v[7]);
          *(u32x4*)(dst + (size_t)(n0 + nn) * DM + 512 + k0 + k8) = w; }
        __syncthreads();
    }
    base += ntiles;
}

__device__ __forceinline__ void dsincos(double th, double& s, double& c) {
    const double k = rint(th * 0.63661977236758134308);
    const double r = (th - k * 1.57079632679489655800) - k * 6.123233995736766e-17;
    const double r2 = r * r;
    const double sp = r * (1.0 + r2 * (-1.0 / 6 + r2 * (1.0 / 120 + r2 * (-1.0 / 5040 + r2 * (1.0 / 362880 + r2 * (-1.0 / 39916800 + r2 * (1.0 / 6227020800.0)))))));
    const double cp = 1.0 + r2 * (-0.5 + r2 * (1.0 / 24 + r2 * (-1.0 / 720 + r2 * (1.0 / 40320 + r2 * (-1.0 / 3628800 + r2 * (1.0 / 479001600.0 + r2 * (-1.0 / 87178291200.0)))))));
    const int q = ((int)k) & 3;
    s = (q == 0) ? sp : (q == 1) ? cp : (q == 2) ? -sp : -cp;
    c = (q == 0) ? cp : (q == 1) ? -sp : (q == 2) ? -cp : sp;
}

__device__ void prologue(const Params& P, LAS unsigned char* lds) {
    const int tid = threadIdx.x, lane = tid & 63, wave = tid >> 6, G = gridDim.x;
    unsigned char* ws = P.ws;
    {
        const float* x = P.in[0]; bf16_t* hb = (bf16_t*)(ws + WS_HB0); unsigned char* lo = ws + WS_LO; float* ssp = (float*)(ws + WS_SSP0);
        for (int row = blockIdx.x * 8 + wave; row < TT; row += G * 8) {
            float ss = 0.f;
#pragma unroll
            for (int q = 0; q < 4; ++q) { const f32x4 v = *(const f32x4*)(x + (size_t)row * DM + q * 256 + lane * 4);
                ss += (v[0] * v[0] + v[1] * v[1]) + (v[2] * v[2] + v[3] * v[3]);
                u32x2 w; w.x = cvt_pk_bf16(v[0], v[1]); w.y = cvt_pk_bf16(v[2], v[3]); *(u32x2*)(hb + (size_t)row * DM + q * 256 + lane * 4) = w;
                *(unsigned*)(lo + (size_t)row * DM + q * 256 + lane * 4) = lo_pack4(v[0] - bflo(w.x), v[1] - bfhi(w.x), v[2] - bflo(w.y), v[3] - bfhi(w.y)); }
#pragma unroll
            for (int o = 32; o >= 1; o >>= 1) ss += __shfl_xor(ss, o);
            if (lane < 16) ssp[(size_t)lane * TT + row] = (lane == 0) ? ss : 0.f;
        }
    }
    {
        LAS float* t = (LAS float*)lds; int base = 0;
        for (int l = 0; l < NLAYER; ++l) {
            bf16_t* W = (bf16_t*)(ws + WS_W) + (size_t)l * LW;
            convT(P.in[3] + (size_t)l * DM * 2 * FF, 2 * FF, P.in[2] + l * DM, W + W_WI1, DM, DM, 2 * FF, 1, t, base);
            convT(P.in[4] + (size_t)l * FF * DM, DM, nullptr, W + W_WO1, FF, FF, DM, 0, t, base);
            convT(P.in[6] + (size_t)l * DM * DM, DM, P.in[5] + l * DM, W + W_WIN, DM, DM, DM, 0, t, base);
            convT(P.in[15] + (size_t)l * 512 * 512, 512, nullptr, W + W_GLU, 512, 512, 512, 0, t, base);
            convT(P.in[18] + (size_t)l * DM * DM, DM, nullptr, W + W_OUT, DM, 512, DM, 0, t, base);
            conv_poolout(P.in[16] + (size_t)l * 4 * 128 * 128, P.in[17] + l * 512, P.in[18] + (size_t)l * DM * DM, W + W_OUT, t, base);
            convT(P.in[20] + (size_t)l * DM * 2 * FF, 2 * FF, P.in[19] + l * DM, W + W_WI2, DM, DM, 2 * FF, 1, t, base);
            convT(P.in[21] + (size_t)l * FF * DM, DM, nullptr, W + W_WO2, FF, FF, DM, 0, t, base);
            convT(P.in[23] + (size_t)l * DM * DM, DM, P.in[22] + l * DM, W + W_GATE, DM, DM, DM, 0, t, base);
            convT(P.in[24] + (size_t)l * 256 * DM, DM, nullptr, W + W_PLE, 256, 256, DM, 0, t, base);
        }
    }
    {
        const int gt = blockIdx.x * NTHREADS + tid, nthr = G * NTHREADS;
        for (int it = gt; it < NLAYER * 2048; it += nthr) {
            const int l = it >> 11, gp = it & 2047, g = gp >> 6;
            const double lr = P.in[7][it], li = P.in[8][it]; const double dt = (double)expf(P.in[9][l * 32 + g]);
            double sn, cs; dsincos(li * dt, sn, cs); const double mag = (double)expf((float)(lr * dt));
            const float ar = (float)(mag * cs), ai = (float)(mag * sn);
            unsigned char* sb = ws + WS_SSM + (size_t)l * SSM_LBYTES;
            ((float*)(sb + SSM_LAMB))[gp * 2] = ar; ((float*)(sb + SSM_LAMB))[gp * 2 + 1] = ai;
            double pr = ar, pi = ai;
#pragma unroll
            for (int s = 0; s < 10; ++s) { const double nr = pr * pr - pi * pi, ni = 2.0 * pr * pi; pr = nr; pi = ni; }
            ((float*)(sb + SSM_LAMB1K))[gp * 2] = (float)pr; ((float*)(sb + SSM_LAMB1K))[gp * 2 + 1] = (float)pi;
            const double nr = mag * cs - 1.0, ni = mag * sn, den = lr * lr + li * li;
            const double qr = (nr * lr + ni * li) / den, qi = (ni * lr - nr * li) / den;
            bf16_t* Bf = (bf16_t*)(sb + SSM_BFRAG) + (size_t)g * 8 * 64 * 4;
            const float* bre = P.in[10] + (size_t)it * 16; const float* bim = P.in[11] + (size_t)it * 16;
            const int p = gp & 63, tq = p >> 4, frr = p & 15;
#pragma unroll
            for (int hh = 0; hh < 16; ++hh) { const double br = bre[hh], bi = bim[hh]; const int ln = (hh >> 2) * 16 + frr, i = hh & 3;
                Bf[((size_t)tq * 64 + ln) * 4 + i] = f2bf((float)(qr * br - qi * bi)); Bf[((size_t)(tq + 4) * 64 + ln) * 4 + i] = f2bf((float)(qr * bi + qi * br)); }
        }
        for (int it = gt; it < NLAYER * 32 * 4 * 64 * 8; it += nthr) {
            const int i = it & 7, ln = (it >> 3) & 63, kt = (it >> 9) & 3, g = (it >> 11) & 31, l = it >> 16;
            const int hh = ln & 15, k = 32 * kt + 8 * (ln >> 4) + i, p = k >> 1;
            const size_t ci = (((size_t)l * 32 + g) * 16 + hh) * 64 + p;
            const float v = (k & 1) ? -P.in[13][ci] : P.in[12][ci];
            ((bf16_t*)(ws + WS_SSM + (size_t)l * SSM_LBYTES + SSM_CFRAG))[it & 65535] = f2bf(v);
        }
    }
}

__device__ __forceinline__ void conv_p(const Params& P, int l) {
    const float* src = P.in[1] + (size_t)l * TT * 256; bf16_t* dst = (bf16_t*)(P.ws + WS_PB);
    const size_t n8 = (size_t)TT * 256 / 8, stride = (size_t)gridDim.x * NTHREADS;
    size_t i = (size_t)blockIdx.x * NTHREADS + threadIdx.x;
    for (; i + 3 * stride < n8; i += 4 * stride) {
        f32x4 a[4], b[4];
#pragma unroll
        for (int q = 0; q < 4; ++q) { a[q] = *(const f32x4*)(src + (i + q * stride) * 8); b[q] = *(const f32x4*)(src + (i + q * stride) * 8 + 4); }
#pragma unroll
        for (int q = 0; q < 4; ++q) { u32x4 w; w.x = cvt_pk_bf16(a[q][0], a[q][1]); w.y = cvt_pk_bf16(a[q][2], a[q][3]); w.z = cvt_pk_bf16(b[q][0], b[q][1]); w.w = cvt_pk_bf16(b[q][2], b[q][3]);
            *(u32x4*)(dst + (i + q * stride) * 8) = w; }
    }
    for (; i < n8; i += stride) {
        const f32x4 a = *(const f32x4*)(src + i * 8), b = *(const f32x4*)(src + i * 8 + 4);
        u32x4 w; w.x = cvt_pk_bf16(a[0], a[1]); w.y = cvt_pk_bf16(a[2], a[3]); w.z = cvt_pk_bf16(b[0], b[1]); w.w = cvt_pk_bf16(b[2], b[3]);
        *(u32x4*)(dst + i * 8) = w;
    }
}

typedef short bf16x4 __attribute__((ext_vector_type(4)));
template <int PASS> __device__ void ssm_pass(const Params& P, int l, LAS unsigned char* lds) {
    int tid = threadIdx.x; asm volatile("" : "+v"(tid));
    const int lane = tid & 63, wave = __builtin_amdgcn_readfirstlane(tid >> 6), G = gridDim.x, fr = lane & 15, fq = lane >> 4;
    unsigned char* ws = P.ws;
    const bf16_t* z = (const bf16_t*)(ws + WS_BIG + BIG_Z); float* E = (float*)(ws + WS_BIG + BIG_E); bf16_t* ypre = (bf16_t*)(ws + WS_BIG + BIG_YPRE);
    const unsigned char* sb = ws + WS_SSM + (size_t)l * SSM_LBYTES;
    const float* lamb = (const float*)(sb + SSM_LAMB); const float* lamb1k = (const float*)(sb + SSM_LAMB1K);
    const bf16_t* Bfrag = (const bf16_t*)(sb + SSM_BFRAG); const bf16_t* Cfrag = (const bf16_t*)(sb + SSM_CFRAG); const float* dskip = P.in[14] + l * 512;
    LAS unsigned char* BU = lds + wave * 12800;
    LAS unsigned char* SI = BU + 8448;
    for (int unit = blockIdx.x; unit < 256; unit += G) {
        const int b = unit >> 4, r = (unit >> 2) & 3, g = (unit & 3) * 8 + wave;
        const size_t tok0 = (size_t)b * SEQ + r * 1024;
        const f32x2 a = *(const f32x2*)(lamb + (g * 64 + lane) * 2);
        bf16x4 bf[8];
#pragma unroll
        for (int t = 0; t < 8; ++t) bf[t] = *(const bf16x4*)(Bfrag + ((size_t)(g * 8 + t) * 64 + lane) * 4);
        float sr = 0.f, si = 0.f;
        bf16x8 cf[4]; f32x4 dd;
        if (PASS == 2) {
            const f32x2 a1k = *(const f32x2*)(lamb1k + (g * 64 + lane) * 2);
            for (int rr = 0; rr < r; ++rr) { const f32x2 e = *(const f32x2*)(E + ((size_t)((b * 32 + g) * 4 + rr) * 64 + lane) * 2);
                const float nr = a1k.x * sr - a1k.y * si + e.x, ni = a1k.x * si + a1k.y * sr + e.y; sr = nr; si = ni; }
#pragma unroll
            for (int kt = 0; kt < 4; ++kt) cf[kt] = *(const bf16x8*)(Cfrag + ((size_t)(g * 4 + kt) * 64 + lane) * 8);
            dd = *(const f32x4*)(dskip + g * 16 + 4 * fq);
        }
        f32x2 sv = {sr, si}; const f32x2 axx = {a.x, a.x}, ayn = {-a.y, a.y};
        const bf16_t* zrow = z + (tok0 + fr) * DM + g * 16 + 4 * fq;
        u32x2 ucur = *(const u32x2*)zrow;
#pragma nounroll
        for (int mt = 0; mt < 64; ++mt) {
            u32x2 unext = ucur; if (mt < 63) unext = *(const u32x2*)(zrow + (size_t)(mt + 1) * 16 * DM);
            const bf16x4 af = __builtin_bit_cast(bf16x4, ucur);
            f32x4 d[8];
#pragma unroll
            for (int t = 0; t < 8; ++t) d[t] = __builtin_amdgcn_mfma_f32_16x16x16bf16_1k(af, bf[t], (f32x4){0.f, 0.f, 0.f, 0.f}, 0, 0, 0);
#pragma unroll
            for (int tq = 0; tq < 4; ++tq)
#pragma unroll
                for (int j = 0; j < 4; ++j) *(LAS f32x2*)(BU + (4 * fq + j) * 528 + (16 * tq + fr) * 8) = (f32x2){d[tq][j], d[tq + 4][j]};
            asm volatile("s_waitcnt lgkmcnt(0)" ::: "memory");
#pragma unroll
            for (int j = 0; j < 16; ++j) {
                const f32x2 bu = *(const LAS f32x2*)(BU + j * 528 + lane * 8);
                sv = __builtin_elementwise_fma(ayn, __builtin_shufflevector(sv, sv, 1, 0), __builtin_elementwise_fma(axx, sv, bu));
                if (PASS == 2) *(LAS unsigned*)(SI + j * 272 + lane * 4) = cvt_pk_bf16(sv.x, sv.y);
            }
            if (PASS == 2) {
                asm volatile("s_waitcnt lgkmcnt(0)" ::: "memory");
                f32x4 acc = (f32x4){0.f, 0.f, 0.f, 0.f};
#pragma unroll
                for (int kt = 0; kt < 4; ++kt) { const bf16x8 sv = *(const LAS bf16x8*)(SI + fr * 272 + (32 * kt + 8 * fq) * 2);
                    acc = __builtin_amdgcn_mfma_f32_16x16x32_bf16(cf[kt], sv, acc, 0, 0, 0); }
                const size_t tok = tok0 + 16 * mt + fr;
                float o[4];
                const float uf[4] = {bflo(ucur.x), bfhi(ucur.x), bflo(ucur.y), bfhi(ucur.y)};
#pragma unroll
                for (int j = 0; j < 4; ++j) { const float y = acc[j] + dd[j] * uf[j]; o[j] = y * fsigmoid(1.5957691216057308f * (y + 0.044715f * y * y * y)); }
                u32x2 w; w.x = cvt_pk_bf16(o[0], o[1]); w.y = cvt_pk_bf16(o[2], o[3]);
                *(u32x2*)(ypre + tok * 512 + g * 16 + 4 * fq) = w;
            }
            asm volatile("" ::: "memory");
            ucur = unext;
        }
        if (PASS == 1) *(f32x2*)(E + ((size_t)((b * 32 + g) * 4 + r) * 64 + lane) * 2) = sv;
    }
}

__device__ __forceinline__ float bf2f(bf16_t v) { return __uint_as_float(((unsigned)v) << 16); }
template <int W> __device__ __forceinline__ void pool_round2(const bf16_t* zpa, bf16_t* mpa, const bf16_t* zpb, bf16_t* mpb, int t0) {
    float a[W - 1 + 16], c[W - 1 + 16];
#pragma unroll
    for (int i = 0; i < W - 1 + 16; ++i) { const int t = t0 - (W - 1) + i; a[i] = (t >= 0) ? bf2f(zpa[(size_t)t * DM]) : 0.f; c[i] = (t >= 0) ? bf2f(zpb[(size_t)t * DM]) : 0.f; }
    float sa = 0.f, sc = 0.f;
#pragma unroll
    for (int i = 0; i < W - 1; ++i) { sa += a[i]; sc += c[i]; }
#pragma unroll
    for (int j = 0; j < 16; ++j) {
        const int t = t0 + j; const float va = a[W - 1 + j], vc = c[W - 1 + j]; sa += va; sc += vc;
        const float inv = 1.0f / (float)((t + 1 < W) ? t + 1 : W);
        mpa[(size_t)t * DM] = f2bf(sa * inv - va); mpb[(size_t)t * DM] = f2bf(sc * inv - vc);
        sa -= a[j]; sc -= c[j];
    }
}
__device__ void pool_phase(const Params& P) {
    int tid = threadIdx.x; asm volatile("" : "+v"(tid));
    const int G = gridDim.x; unsigned char* ws = P.ws;
    const bf16_t* z = (const bf16_t*)(ws + WS_BIG + BIG_Z); bf16_t* mix = (bf16_t*)(ws + WS_BIG + BIG_MIX);
    const int ch = tid, gi = __builtin_amdgcn_readfirstlane(ch >> 7);
    for (int q = blockIdx.x; q < 2048; q += G) {
        const int t0 = (q & 255) * 16, b0 = (q >> 8) * 2;
        const bf16_t* zpa = z + (size_t)b0 * SEQ * DM + 512 + ch; bf16_t* mpa = mix + (size_t)b0 * SEQ * DM + 512 + ch;
        const bf16_t* zpb = zpa + (size_t)SEQ * DM; bf16_t* mpb = mpa + (size_t)SEQ * DM;
        if (gi == 0) pool_round2<2>(zpa, mpa, zpb, mpb, t0); else if (gi == 1) pool_round2<4>(zpa, mpa, zpb, mpb, t0); else if (gi == 2) pool_round2<8>(zpa, mpa, zpb, mpb, t0); else pool_round2<16>(zpa, mpa, zpb, mpb, t0);
    }
}

__device__ void final_norm(const Params& P, const float* ssp, const bf16_t* hi, const unsigned char* lo) {
    const int tid = threadIdx.x, lane = tid & 63, wave = tid >> 6, G = gridDim.x;
    float* out = P.out; const float* fn = P.in[25];
    f32x4 w[4];
#pragma unroll
    for (int q = 0; q < 4; ++q) w[q] = *(const f32x4*)(fn + q * 256 + lane * 4);
    for (int row = blockIdx.x * 8 + wave; row < TT; row += G * 8) {
        float ss = (lane < 16) ? ssp[(size_t)lane * TT + row] : 0.f;
        u32x2 hv[4]; unsigned lv[4];
#pragma unroll
        for (int q = 0; q < 4; ++q) { hv[q] = *(const u32x2*)(hi + (size_t)row * DM + q * 256 + lane * 4); lv[q] = *(const unsigned*)(lo + (size_t)row * DM + q * 256 + lane * 4); }
#pragma unroll
        for (int o = 32; o >= 1; o >>= 1) ss += __shfl_xor(ss, o);
        const float r = 1.0f / sqrtf(ss * (1.0f / 1024.0f) + 1e-6f);
#pragma unroll
        for (int q = 0; q < 4; ++q) { const f32x4 v = (f32x4){bflo(hv[q].x), bfhi(hv[q].x), bflo(hv[q].y), bfhi(hv[q].y)} + lo_unpack4(lv[q]);
            *(f32x4*)(out + (size_t)row * DM + q * 256 + lane * 4) = v * r * w[q]; }
    }
}

__global__ void __launch_bounds__(NTHREADS, 2) mega_fwd(Params P) {
    extern __shared__ __attribute__((aligned(16))) unsigned char lds_raw[];
    LAS unsigned char* lds = (LAS unsigned char*)lds_raw;
    LAS float* rs = (LAS float*)(lds + STAGE_LDS);
    cg::grid_group grid = cg::this_grid();
#ifndef PHMASK
#define PHMASK 0xFFFF
#endif
#define HBC(l) ((bf16_t*)(wsb + (((l) & 1) ? WS_HB1 : WS_HB0)))
#define HBN(l) ((bf16_t*)(wsb + (((l) & 1) ? WS_HB0 : WS_HB1)))
#define SSPC(l) ((float*)(wsb + (((l) & 1) ? WS_SSP1 : WS_SSP0)))
#define SSPN(l) ((float*)(wsb + (((l) & 1) ? WS_SSP0 : WS_SSP1)))
#define WL(l) ((const bf16_t*)(wsb + WS_W) + (size_t)(l) * LW)
#define BIGP(T_, off) ((T_*)(wsb + WS_BIG + (off)))
#define LOP ((unsigned char*)(wsb + WS_LO))
    volatile LAS unsigned* xbst = (volatile LAS unsigned*)(lds + LDS_BYTES - 16);
    if (threadIdx.x < 4) xbst[threadIdx.x] = 0u;
    __syncthreads();
    const XcdBarrier xbar = xcd_barrier_post((unsigned*)(P.ws + WS_BAR), xbst);
    if (PHMASK & 1) prologue(P, lds);
    grid.sync();

    for (int ph = 0; ph < NLAYER * 11; ++ph) {
        const int l = ph / 11, k = ph - l * 11;
#ifndef REPK
#define REPK -1
#define REPN 1
#endif
        for (int rep = 0; rep < ((k == REPK) ? REPN : 1); ++rep) {
        int G = gridDim.x, cid = blockIdx.x; unsigned char* wsb = P.ws; asm volatile("" : "+s"(G), "+s"(cid), "+s"(wsb));
        switch (k) {
        case 0: if (PHMASK & 2) {
            pg8::RevOrder S; S.init(TT, 2 * FF, G, cid); build_rs(rs, SSPC(l));
            pg8::Gemm g{HBC(l), WL(l) + W_WI1, TT, 2 * FF, DM}; EpiSwiGLU E{BIGP(bf16_t, BIG_HID), rs}; pg8::gemm_phase(lds, g, S, E); } break;
        case 1: if (PHMASK & 4) {
            pg8::StaticOrder S; S.init(TT, DM, G, cid);
            pg8::Gemm g{BIGP(bf16_t, BIG_HID), WL(l) + W_WO1, TT, DM, FF}; EpiH<0> E{HBC(l), HBC(l), LOP, SSPC(l), 0.5f, nullptr, rs}; pg8::gemm_phase(lds, g, S, E); } break;
        case 2: if (PHMASK & 8) {
            pg8::RevOrder S; S.init(TT, DM, G, cid); build_rs(rs, SSPC(l));
            pg8::Gemm g{HBC(l), WL(l) + W_WIN, TT, DM, DM}; EpiZ E{BIGP(bf16_t, BIG_Z), rs}; pg8::gemm_phase(lds, g, S, E); } break;
        case 3: if (PHMASK & 16) {
            ssm_pass<1>(P, l, lds); pool_phase(P); conv_p(P, l); } break;
        case 4: if (PHMASK & 32) {
            ssm_pass<2>(P, l, lds); } break;
        case 5: if (PHMASK & 64) {
            pg8::StaticOrder S; S.init(TT, 512, G, cid);
            pg8::Gemm g{BIGP(bf16_t, BIG_YPRE), WL(l) + W_GLU, TT, 512, 512}; EpiGLU E{BIGP(bf16_t, BIG_YPRE), BIGP(bf16_t, BIG_MIX)}; pg8::gemm_phase(lds, g, S, E); } break;
        case 6: if (PHMASK & 128) {
            pg8::RevOrder S; S.init(TT, DM, G, cid);
            pg8::Gemm g{BIGP(bf16_t, BIG_MIX), WL(l) + W_OUT, TT, DM, DM}; EpiH<0> E{HBC(l), HBC(l), LOP, SSPC(l), 1.0f, nullptr, rs}; pg8::gemm_phase(lds, g, S, E); } break;
        case 7: if (PHMASK & 256) {
            pg8::StaticOrder S; S.init(TT, 2 * FF, G, cid); build_rs(rs, SSPC(l));
            pg8::Gemm g{HBC(l), WL(l) + W_WI2, TT, 2 * FF, DM}; EpiSwiGLU E{BIGP(bf16_t, BIG_HID), rs}; pg8::gemm_phase(lds, g, S, E); } break;
        case 8: if (PHMASK & 512) {
            pg8::RevOrder S; S.init(TT, DM, G, cid);
            pg8::Gemm g{BIGP(bf16_t, BIG_HID), WL(l) + W_WO2, TT, DM, FF}; EpiH<0> E{HBC(l), HBC(l), LOP, SSPC(l), 0.5f, nullptr, rs}; pg8::gemm_phase(lds, g, S, E); } break;
        case 9: if (PHMASK & 1024) {
            pg8::StaticOrder S; S.init(TT, DM, G, cid); build_rs(rs, SSPC(l));
            pg8::Gemm g{(const bf16_t*)(wsb + WS_PB), WL(l) + W_PLE, TT, DM, 256}; EpiProj E{BIGP(bf16_t, BIG_PROJ)}; pg8::gemm_phase(lds, g, S, E); } break;
        default: if (PHMASK & 1024) {
            pg8::StaticOrder S; S.init(TT, DM, G, cid);
            pg8::Gemm g{HBC(l), WL(l) + W_GATE, TT, DM, DM}; EpiH<1> E{HBC(l), HBN(l), LOP, SSPN(l), 1.0f, BIGP(bf16_t, BIG_PROJ), rs}; pg8::gemm_phase(lds, g, S, E); } break;
        }
        if (k != 9) xcd_barrier(xbar);
        }
    }
    if (PHMASK & 0x800) final_norm(P, (const float*)(P.ws + ((NLAYER & 1) ? WS_SSP1 : WS_SSP0)), (const bf16_t*)(P.ws + ((NLAYER & 1) ? WS_HB1 : WS_HB0)), (const unsigned char*)(P.ws + WS_LO));
}

extern "C" void kernel_launch(void* const* d_in, const int* in_sizes, int n_in, void* d_out, int out_size, void* d_ws, size_t ws_size, hipStream_t stream) {
    static int grid_blocks = 0;
    if (!grid_blocks) {
        int dev = 0, cus = 0, per_cu = 0;
        hipGetDevice(&dev);
        hipDeviceGetAttribute(&cus, hipDeviceAttributeMultiprocessorCount, dev);
        if (hipFuncSetAttribute((const void*)mega_fwd, hipFuncAttributeMaxDynamicSharedMemorySize, LDS_BYTES) != hipSuccess) fprintf(stderr, "hipFuncSetAttribute failed\n");
        if (hipOccupancyMaxActiveBlocksPerMultiprocessor(&per_cu, (const void*)mega_fwd, NTHREADS, LDS_BYTES) != hipSuccess || per_cu < 1) { per_cu = 1; (void)hipGetLastError(); }
        grid_blocks = cus * 1;
        if (ws_size < WS_END) fprintf(stderr, "workspace too small: %zu < %zu\n", ws_size, (size_t)WS_END);
    }
    Params p{};
    for (int i = 0; i < 26; ++i) p.in[i] = (const float*)d_in[i];
    p.out = (float*)d_out; p.ws = (unsigned char*)d_ws;
    if (hipMemsetAsync((char*)d_ws + WS_BAR, 0, 16384, stream) != hipSuccess) fprintf(stderr, "memset of barrier words failed\n");
    void* args[] = {&p};
    hipError_t e = hipLaunchCooperativeKernel((void*)mega_fwd, dim3(grid_blocks), dim3(NTHREADS), args, LDS_BYTES, stream);
    if (e != hipSuccess) fprintf(stderr, "cooperative launch failed: %s (grid %d)\n", hipGetErrorString(e), grid_blocks);
}
```

```cpp
#include <hip/hip_runtime.h>
#include <hip/hip_cooperative_groups.h>
#include <cstdio>
namespace cg = cooperative_groups;

#define LAS __attribute__((address_space(3)))
typedef unsigned short bf16_t;
typedef short bf16x8 __attribute__((ext_vector_type(8)));
typedef float f32x4 __attribute__((ext_vector_type(4)));
typedef float f32x2 __attribute__((ext_vector_type(2)));
typedef unsigned u32x4 __attribute__((ext_vector_type(4)));
typedef unsigned u32x2 __attribute__((ext_vector_type(2)));

constexpr int TT = 65536;
constexpr int SEQ = 4096;
constexpr int DM = 1024;
constexpr int FF = 2816;
constexpr int NLAYER = 4;
constexpr int NTHREADS = 512;
constexpr int STAGE_LDS = 131072;
constexpr int RS_LDS = 24576;
constexpr int LDS_BYTES = STAGE_LDS + RS_LDS;

constexpr size_t WS_HB0 = 0;
constexpr size_t WS_HB1 = 134217728ull;
constexpr size_t WS_BIG = 268435456ull;
constexpr size_t BIG_HID = 0, BIG_Z = 0, BIG_PROJ = 0, BIG_MIX = 134217728ull, BIG_YPRE = 268435456ull, BIG_E = 335544320ull;
constexpr size_t BIG_SIZE = 369098752ull;
constexpr size_t WS_PB = WS_BIG + BIG_SIZE;
constexpr size_t WS_W = WS_PB + 33554432ull;
constexpr size_t LW = 20971520ull;
constexpr size_t W_WI1 = 0, W_WO1 = 5767168, W_WIN = 8650752, W_GLU = 9699328, W_OUT = 9961472, W_WI2 = 11010048, W_WO2 = 16777216, W_GATE = 19660800, W_PLE = 20709376;
constexpr size_t WS_SSP0 = WS_W + LW * 2 * NLAYER;
constexpr size_t WS_SSP1 = WS_SSP0 + 4194304ull;
constexpr size_t WS_SSM = WS_SSP1 + 4194304ull;
constexpr size_t SSM_LAMB = 0, SSM_LAMB1K = 16384, SSM_BFRAG = 32768, SSM_CFRAG = 32768 + 131072, SSM_LBYTES = 32768 + 131072 + 131072;
constexpr size_t WS_BAR = WS_SSM + SSM_LBYTES * NLAYER;
constexpr size_t WS_LO = WS_BAR + 16384;
constexpr size_t WS_END = WS_LO + 134217728ull;

struct Params { const float* in[26]; float* out; unsigned char* ws; };
#define GAS __attribute__((address_space(1)))
#define GP(T_, p) ((GAS T_*)(p))

typedef __bf16 bfx2_t __attribute__((ext_vector_type(2)));
__device__ __forceinline__ unsigned cvt_pk_bf16(float lo, float hi) { const f32x2 v = {lo, hi}; return __builtin_bit_cast(unsigned, __builtin_convertvector(v, bfx2_t)); }
__device__ __forceinline__ bf16_t f2bf(float f) { unsigned u = __float_as_uint(f); u += 0x7FFFu + ((u >> 16) & 1u); return (bf16_t)(u >> 16); }
__device__ __forceinline__ float bflo(unsigned w) { return __uint_as_float(w << 16); }
__device__ __forceinline__ float bfhi(unsigned w) { return __uint_as_float(w & 0xffff0000u); }
__device__ __forceinline__ unsigned lo_pack4(float a, float b, float c, float d) { int p = __builtin_amdgcn_cvt_pk_fp8_f32(a * 512.0f, b * 512.0f, 0, false); return (unsigned)__builtin_amdgcn_cvt_pk_fp8_f32(c * 512.0f, d * 512.0f, p, true); }
__device__ __forceinline__ f32x4 lo_unpack4(unsigned w) { const f32x2 a = __builtin_amdgcn_cvt_pk_f32_fp8((int)w, false), b = __builtin_amdgcn_cvt_pk_f32_fp8((int)w, true); return (f32x4){a.x, a.y, b.x, b.y} * (1.0f / 512.0f); }
__device__ __forceinline__ float fsigmoid(float x) { return __builtin_amdgcn_rcpf(1.0f + __builtin_amdgcn_exp2f(-1.4426950408889634f * x)); }


#define XB_TMO      128
#define XB_XCNT(j)  (256  + 64 * (j))
#define XB_XSUB(j)  (1280 + 64 * (j))
#define XB_XGEN(j)  (2304 + 64 * (j))
#define XB_TOP      3328
#define XB_TOPGEN   3392
#define XCD_BAR_WORDS 3456
#define XB_SPIN_CAP (1u << 18)
__device__ __forceinline__ unsigned xb_ld(unsigned* p)              { return __hip_atomic_load(p, __ATOMIC_RELAXED, __HIP_MEMORY_SCOPE_AGENT); }
__device__ __forceinline__ unsigned xb_add(unsigned* p, unsigned v) { return __hip_atomic_fetch_add(p, v, __ATOMIC_RELAXED, __HIP_MEMORY_SCOPE_AGENT); }
__device__ __forceinline__ unsigned xb_xcc_id() { return (unsigned)__builtin_amdgcn_s_getreg((3 << 11) | 20) & 0xFu; }
#define XB_SPIN(cond, bar) do { unsigned _sp = 0; while (cond) { __builtin_amdgcn_s_sleep(1); \
    if ((++_sp & 255u) == 0u) { if (xb_ld(&(bar)[XB_TMO])) break; if (_sp > XB_SPIN_CAP) { atomicAdd(&(bar)[XB_TMO], 1u); break; } } } } while (0)
struct XcdBarrier { unsigned* bar; unsigned x; volatile LAS unsigned* st; };
__device__ __forceinline__ XcdBarrier xcd_barrier_post(unsigned* bar, volatile LAS unsigned* st) {
    XcdBarrier b; b.bar = bar; b.x = xb_xcc_id(); b.st = st;
    if (threadIdx.x == 0) (void)xb_add(&bar[XB_XCNT(b.x)], 1u);
    return b;
}
__device__ __forceinline__ void xcd_barrier_complete(unsigned* bar, unsigned x, unsigned& nloc, unsigned& nx) {
    const unsigned G = gridDim.x * gridDim.y * gridDim.z;
    unsigned sum, cnt, mine, sp = 0u;
    for (;;) {
        sum = 0u; cnt = 0u; mine = 0u;
#pragma unroll
        for (unsigned j = 0; j < 16; ++j) { const unsigned c = xb_ld(&bar[XB_XCNT(j)]); sum += c; cnt += (c > 0u) ? 1u : 0u; mine = (j == x) ? c : mine; }
        if (sum == G) break;
        __builtin_amdgcn_s_sleep(1);
        if ((++sp & 255u) == 0u) { if (xb_ld(&bar[XB_TMO])) break; if (sp > XB_SPIN_CAP) { atomicAdd(&bar[XB_TMO], 1u); break; } }
    }
    nloc = mine > 0u ? mine : 1u; nx = cnt > 0u ? cnt : 1u;
}
__device__ __forceinline__ void xcd_barrier(const XcdBarrier& b) {
    asm volatile("s_waitcnt vmcnt(0)" ::: "memory");
    __syncthreads();
    if (threadIdx.x == 0) {
        unsigned* bar = b.bar;
        __builtin_amdgcn_s_waitcnt(0);
        unsigned nloc = b.st[0], nx = b.st[1];
        if (nloc == 0u) { xcd_barrier_complete(bar, b.x, nloc, nx); b.st[0] = nloc; b.st[1] = nx; }
        const unsigned old = xb_add(&bar[XB_XSUB(b.x)], 1u);
        const unsigned gen = old / nloc;
        if (old + 1u == (gen + 1u) * nloc) {
            __builtin_amdgcn_fence(__ATOMIC_RELEASE, "agent");
            asm volatile("s_waitcnt vmcnt(0)" ::: "memory");
            const unsigned og = xb_add(&bar[XB_TOP], 1u);
            const unsigned tg = og / nx;
            if (og + 1u == (tg + 1u) * nx) xb_add(&bar[XB_TOPGEN], 1u);
            else XB_SPIN(xb_ld(&bar[XB_TOPGEN]) == tg, bar);
            __builtin_amdgcn_fence(__ATOMIC_ACQUIRE, "agent");
            xb_add(&bar[XB_XGEN(b.x)], 1u);
            asm volatile("s_waitcnt vmcnt(0)" ::: "memory");
        } else {
            XB_SPIN(xb_ld(&bar[XB_XGEN(b.x)]) == gen, bar);
            __builtin_amdgcn_fence(__ATOMIC_ACQUIRE, "agent");
            asm volatile("s_waitcnt vmcnt(0)" ::: "memory");
        }
    }
    __syncthreads();
}

namespace pg8 {
constexpr int BM = 256, BK = 64, HALF = 128, HTB = HALF * BK * 2, NXCD = 8, WGM = 8;
__device__ __forceinline__ int lds_byte(int r, int c) { const int st = (r >> 4) * 2 + (c >> 5), rr = r & 15, cc = c & 31, ob = rr * 64 + cc * 2; return st * 1024 + (ob ^ (((ob >> 9) & 1) << 5)); }
__device__ __forceinline__ void stage_rc(int b, int& R, int& C) { const int st = b / 1024, sb = b % 1024, swz = sb ^ (((sb >> 9) & 1) << 5); R = (st >> 1) * 16 + swz / 64; C = (st & 1) * 32 + (swz % 64) / 2; }
__device__ __forceinline__ int perm32(int rho) { const int n = rho >> 4, i = rho & 15; return 8 * (i >> 2) + 4 * n + (i & 3); }
struct Unit { int pm, pn; };
struct Gemm { const bf16_t* A; const bf16_t* Bt; int M, N, K; };
struct StaticOrder {
    int nM, nN, nwg, G, c;
    __device__ void init(int M, int N, int G_, int c_) { nM = M / BM; nN = N / BM; nwg = nM * nN; G = G_; c = c_; }
    __device__ bool next(int i, Unit& u) const {
        const long L = (long)i * G + c; if (L >= nwg) return false;
        int wgid = (int)L; { const int q = nwg / NXCD, r = nwg % NXCD, xcd = wgid % NXCD, off = wgid / NXCD; wgid = (xcd < r ? xcd * (q + 1) : r * (q + 1) + (xcd - r) * q) + off; }
        const int nig = WGM * nN, gid = wgid / nig, fm = gid * WGM, gsz = (nM - fm) < WGM ? (nM - fm) : WGM;
        u.pm = fm + ((wgid % nig) % gsz); u.pn = (wgid % nig) / gsz; return true;
    }
};
struct RevOrder : StaticOrder { __device__ bool next(int i, Unit& u) const { const int nr = (nwg + G - 1) / G; if (i < 0 || i >= nr) return false; return StaticOrder::next(nr - 1 - i, u); } };
template <class Epi, class Ord>
__device__ __forceinline__ void gemm_phase(LAS unsigned char* lds, const Gemm g, const Ord& S, const Epi& E) {
    int tid = threadIdx.x; asm volatile("" : "+v"(tid));
    const int wid = __builtin_amdgcn_readfirstlane(tid >> 6), lane = tid & 63, wr = wid >> 2, wc = wid & 3, fr = lane & 15, fq = lane >> 4;
    int K = g.K; asm volatile("" : "+s"(K));
    const int nt = K / BK;
    unsigned voffA[2], voffB[2];
#pragma unroll
    for (int i = 0; i < 2; ++i) { int R, C; stage_rc(tid * 16 + i * 8192, R, C); const int Rb = (R & ~31) + perm32(R & 31);
        voffA[i] = (unsigned)(R * K + C) * 2u; voffB[i] = (unsigned)(Rb * K + C) * 2u; }
    const size_t kstep = (size_t)(BK * 2);
    const size_t hstep = (size_t)HALF * K * 2;
    const size_t tstep = 2 * hstep;
    const unsigned ldsw = (unsigned)wid * 1024u;
    const int aoff = lds_byte(wr * 64 + fr, fq * 8), boff = lds_byte(wc * 32 + fr, fq * 8);
#define PG8_SA(b, h) (((b) * 2 + (h)) * HTB)
#define PG8_SB(b, h) ((4 + (b) * 2 + (h)) * HTB)
#define PG8_STAGE(bufoff, gbase, voff) do { const char* _gb = (const char*)(gbase); asm volatile("" : "+s"(_gb)); _Pragma("unroll") for (int _i = 0; _i < 2; ++_i) { unsigned _vo = (voff)[_i]; asm volatile("" : "+v"(_vo)); \
        __builtin_amdgcn_global_load_lds((const GAS unsigned*)(_gb + _vo), (LAS unsigned*)(lds + (bufoff) + ldsw + _i * 8192), 16, 0, 0); } } while (0)
#define PG8_LDA(dst, b, h) do { _Pragma("unroll") for (int m = 0; m < 4; ++m) _Pragma("unroll") for (int k = 0; k < 2; ++k) dst[m][k] = *(const LAS bf16x8*)(lds + PG8_SA(b, h) + aoff + m * 2048 + k * 1024); } while (0)
#define PG8_LDB(dst, b, h) do { _Pragma("unroll") for (int n = 0; n < 2; ++n) _Pragma("unroll") for (int k = 0; k < 2; ++k) dst[n][k] = *(const LAS bf16x8*)(lds + PG8_SB(b, h) + boff + n * 2048 + k * 1024); } while (0)
#define PG8_MMA(ai, bj, At, Bt) do { __builtin_amdgcn_s_setprio(1); _Pragma("unroll") for (int m = 0; m < 4; ++m) _Pragma("unroll") for (int n = 0; n < 2; ++n) _Pragma("unroll") for (int k = 0; k < 2; ++k) \
        acc[ai][bj][m][n] = __builtin_amdgcn_mfma_f32_16x16x32_bf16(Bt[n][k], At[m][k], acc[ai][bj][m][n], 0, 0, 0); __builtin_amdgcn_s_setprio(0); } while (0)
#define PG8_WAIT_V(n) asm volatile("s_waitcnt vmcnt(" #n ")" ::: "memory")
#define PG8_WAIT_L(n) asm volatile("s_waitcnt lgkmcnt(" #n ")" ::: "memory")
#define PG8_BAR __builtin_amdgcn_s_barrier()
#define PG8_SCHED __builtin_amdgcn_sched_barrier(0)
    Unit cur, nxt; int ui = 0;
    if (!S.next(0, cur)) return;
    f32x4 acc[2][2][4][2];
#pragma unroll
    for (int a = 0; a < 2; ++a)
#pragma unroll
        for (int b = 0; b < 2; ++b)
#pragma unroll
            for (int m = 0; m < 4; ++m)
#pragma unroll
                for (int n = 0; n < 2; ++n) acc[a][b][m][n] = (f32x4){0.f, 0.f, 0.f, 0.f};
    bf16x8 At[4][2], B0[2][2], B1[2][2];
    const char* cA = (const char*)g.A + (size_t)cur.pm * tstep; const char* cB = (const char*)g.Bt + (size_t)cur.pn * tstep;
    PG8_STAGE(PG8_SB(0, 0), cB, voffB); PG8_STAGE(PG8_SA(0, 0), cA, voffA); PG8_STAGE(PG8_SB(0, 1), cB + hstep, voffB); PG8_STAGE(PG8_SA(0, 1), cA + hstep, voffA);
    if (wr == 1) PG8_BAR;
    PG8_WAIT_V(4); PG8_BAR;
    PG8_STAGE(PG8_SB(1, 0), cB + kstep, voffB); PG8_STAGE(PG8_SA(1, 0), cA + kstep, voffA); PG8_STAGE(PG8_SB(1, 1), cB + hstep + kstep, voffB);
    PG8_WAIT_V(6); PG8_BAR;
    for (;;) {
        const bool has_next = S.next(ui + 1, nxt);
        const char* nA = has_next ? (const char*)g.A + (size_t)nxt.pm * tstep : cA; const char* nB = has_next ? (const char*)g.Bt + (size_t)nxt.pn * tstep : cB;
#pragma nounroll
        for (int t = 0; t < nt; t += 2) {
            const bool last = (t == nt - 2);
            const char* a1 = cA + (size_t)(t + 1) * kstep;
            const char* a2 = last ? nA : cA + (size_t)(t + 2) * kstep; const char* b2 = last ? nB : cB + (size_t)(t + 2) * kstep;
            const char* a3 = a2 + kstep; const char* b3 = b2 + kstep;
            PG8_LDB(B0, 0, 0); PG8_SCHED; PG8_LDA(At, 0, 0); PG8_STAGE(PG8_SA(1, 1), a1 + hstep, voffA);
            PG8_WAIT_L(8); PG8_BAR; PG8_WAIT_L(0); PG8_MMA(0, 0, At, B0); PG8_BAR; PG8_SCHED;
            PG8_LDB(B1, 0, 1); PG8_STAGE(PG8_SB(0, 0), b2, voffB);
            PG8_BAR; PG8_WAIT_L(0); PG8_MMA(0, 1, At, B1); PG8_BAR;
            PG8_LDA(At, 0, 1); PG8_STAGE(PG8_SA(0, 0), a2, voffA);
            PG8_BAR; PG8_WAIT_L(0); PG8_MMA(1, 0, At, B0); PG8_BAR; PG8_SCHED;
            PG8_STAGE(PG8_SB(0, 1), b2 + hstep, voffB);
            PG8_WAIT_V(6); PG8_BAR; PG8_MMA(1, 1, At, B1); PG8_BAR;
            PG8_LDB(B0, 1, 0); PG8_SCHED; PG8_LDA(At, 1, 0); PG8_STAGE(PG8_SA(0, 1), a2 + hstep, voffA);
            PG8_WAIT_L(8); PG8_BAR; PG8_WAIT_L(0); PG8_MMA(0, 0, At, B0); PG8_BAR; PG8_SCHED;
            PG8_LDB(B1, 1, 1); PG8_STAGE(PG8_SB(1, 0), b3, voffB);
            PG8_BAR; PG8_WAIT_L(0); PG8_MMA(0, 1, At, B1); PG8_BAR;
            PG8_LDA(At, 1, 1); PG8_STAGE(PG8_SA(1, 0), a3, voffA);
            PG8_BAR; PG8_WAIT_L(0); PG8_MMA(1, 0, At, B0); PG8_BAR; PG8_SCHED;
            PG8_STAGE(PG8_SB(1, 1), b3 + hstep, voffB);
            PG8_WAIT_V(6); PG8_BAR; PG8_MMA(1, 1, At, B1); PG8_BAR;
        }
        E(acc, cur, ui, wr, wc, fr, fq);
        if (!has_next) break;
#pragma unroll
        for (int a = 0; a < 2; ++a)
#pragma unroll
            for (int b = 0; b < 2; ++b)
#pragma unroll
                for (int m = 0; m < 4; ++m)
#pragma unroll
                    for (int n = 0; n < 2; ++n) acc[a][b][m][n] = (f32x4){0.f, 0.f, 0.f, 0.f};
        cur = nxt; cA = nA; cB = nB; ++ui;
    }
    PG8_WAIT_V(0);
    if (wr == 0) PG8_BAR;
    PG8_BAR;
#undef PG8_SA
#undef PG8_SB
#undef PG8_STAGE
#undef PG8_LDA
#undef PG8_LDB
#undef PG8_MMA
#undef PG8_WAIT_V
#undef PG8_WAIT_L
#undef PG8_BAR
#undef PG8_SCHED
}
}
using pg8::Unit;
typedef f32x4 AccT[2][2][4][2];

__device__ __forceinline__ size_t tn_slot(int pm, int pn, int wave, int ai, int m, int bj) { return ((size_t)((pm * 4 + pn) * 8 + wave) * 16 + (ai * 4 + m) * 2 + bj); }
__device__ __forceinline__ size_t tn_index(int row, int col) {
    const int pm = row >> 8, rl = row & 255, pn = col >> 8, cl = col & 255;
    const int ai = rl >> 7, wr = (rl >> 6) & 1, m = (rl >> 4) & 3, fr = rl & 15, bj = cl >> 7, wc = (cl >> 5) & 3, fq = (cl >> 3) & 3, e = cl & 7;
    return (tn_slot(pm, pn, wr * 4 + wc, ai, m, bj) * 64 + fq * 16 + fr) * 8 + e;
}
struct EpiSwiGLU {
    bf16_t* O; const LAS float* rs;
    __device__ __forceinline__ void operator()(const AccT& acc, const Unit& u, int ui, int wr, int wc, int fr, int fq) const {
        const int col = u.pn * 128 + wc * 32 + 8 * fq;
#pragma unroll
        for (int ai = 0; ai < 2; ++ai)
#pragma unroll
            for (int m = 0; m < 4; ++m) {
                const int rl = ai * 128 + wr * 64 + m * 16 + fr; const float r = rs[((u.pm >> 3) & 3) * 256 + rl];
                const float nr = -1.4426950408889634f * r, r2 = r * r;
                unsigned w[4];
#pragma unroll
                for (int n = 0; n < 2; ++n)
#pragma unroll
                    for (int hlf = 0; hlf < 2; ++hlf) {
                        const f32x2 a = {acc[ai][0][m][n][2 * hlf], acc[ai][0][m][n][2 * hlf + 1]}, b = {acc[ai][1][m][n][2 * hlf], acc[ai][1][m][n][2 * hlf + 1]};
                        const f32x2 t = a * nr;
                        f32x2 d; d.x = __builtin_amdgcn_exp2f(t.x); d.y = __builtin_amdgcn_exp2f(t.y); d = d + 1.0f;
                        f32x2 q; q.x = __builtin_amdgcn_rcpf(d.x); q.y = __builtin_amdgcn_rcpf(d.y);
                        const f32x2 o = ((a * b) * r2) * q;
                        w[n * 2 + hlf] = cvt_pk_bf16(o.x, o.y);
                    }
                u32x4 wv; wv.x = w[0]; wv.y = w[1]; wv.z = w[2]; wv.w = w[3];
                *GP(u32x4, O + (size_t)(u.pm * 256 + rl) * FF + col) = wv;
            }
    }
};
template <int MODE> struct EpiH {
    const bf16_t* hin; bf16_t* hout; unsigned char* lo; float* ssp; float alpha; const bf16_t* proj; const LAS float* rs;
    template <int NM> __device__ __forceinline__ void round(const AccT& acc, const Unit& u, int ai, int m0, int wr, int wc, int fr, int fq) const {
        u32x4 hv[NM][2], pv[NM][2]; u32x2 lv[NM][2];
#pragma unroll
        for (int mm = 0; mm < NM; ++mm) {
            const int rl = ai * 128 + wr * 64 + (m0 + mm) * 16 + fr;
            const size_t off = (size_t)(u.pm * 256 + rl) * DM + u.pn * 256 + wc * 32 + 8 * fq;
#pragma unroll
            for (int bj = 0; bj < 2; ++bj) {
                const size_t tn = (tn_slot(u.pm, u.pn, wr * 4 + wc, ai, m0 + mm, bj) * 64 + fq * 16 + fr) * 8;
                hv[mm][bj] = *GP(const u32x4, hin + off + bj * 128); lv[mm][bj] = *GP(const u32x2, lo + tn);
                if (MODE == 1) pv[mm][bj] = *GP(const u32x4, proj + tn);
            }
        }
#pragma unroll
        for (int mm = 0; mm < NM; ++mm) {
            const int m = m0 + mm;
            const int rl = ai * 128 + wr * 64 + m * 16 + fr; const int row = u.pm * 256 + rl;
            const size_t off = (size_t)row * DM + u.pn * 256 + wc * 32 + 8 * fq;
            float r = 1.f; if (MODE == 1) r = rs[((u.pm >> 3) & 3) * 256 + rl];
            f32x2 ss2 = {0.f, 0.f};
#pragma unroll
            for (int bj = 0; bj < 2; ++bj) {
                const u32x4 H = hv[mm][bj]; const u32x2 L = lv[mm][bj];
                unsigned wh[4], wl[2] = {0u, 0u};
#pragma unroll
                for (int p = 0; p < 4; ++p) {
                    const unsigned hw = (p == 0) ? H.x : (p == 1) ? H.y : (p == 2) ? H.z : H.w;
                    const f32x2 a2 = {acc[ai][bj][m][p >> 1][2 * (p & 1)], acc[ai][bj][m][p >> 1][2 * (p & 1) + 1]};
                    f32x2 d;
                    if (MODE == 0) d = a2 * alpha;
                    else { const unsigned pw = (p == 0) ? pv[mm][bj].x : (p == 1) ? pv[mm][bj].y : (p == 2) ? pv[mm][bj].z : pv[mm][bj].w;
                        const f32x2 t = a2 * (-1.4426950408889634f * r);
                        f32x2 e; e.x = __builtin_amdgcn_exp2f(t.x); e.y = __builtin_amdgcn_exp2f(t.y); e = e + 1.0f;
                        f32x2 q; q.x = __builtin_amdgcn_rcpf(e.x); q.y = __builtin_amdgcn_rcpf(e.y);
                        d = q * (f32x2){bflo(pw), bfhi(pw)}; }
                    const f32x2 h2 = {bflo(hw), bfhi(hw)};
                    const int lw = (int)((p < 2) ? L.x : L.y);
                    const f32x2 l2 = (p & 1) ? __builtin_amdgcn_cvt_pk_f32_fp8(lw, true) : __builtin_amdgcn_cvt_pk_f32_fp8(lw, false);
                    const f32x2 o = __builtin_elementwise_fma(l2, (f32x2){1.0f / 512.0f, 1.0f / 512.0f}, h2 + d);
                    const unsigned w = cvt_pk_bf16(o.x, o.y); wh[p] = w;
                    const f32x2 rem = (o - (f32x2){bflo(w), bfhi(w)}) * 512.0f;
                    wl[p >> 1] = (p & 1) ? (unsigned)__builtin_amdgcn_cvt_pk_fp8_f32(rem.x, rem.y, (int)wl[p >> 1], true) : (unsigned)__builtin_amdgcn_cvt_pk_fp8_f32(rem.x, rem.y, (int)wl[p >> 1], false);
                    ss2 = __builtin_elementwise_fma(o, o, ss2);
                }
                *GP(u32x4, hout + off + bj * 128) = (u32x4){wh[0], wh[1], wh[2], wh[3]}; *GP(u32x2, lo + (tn_slot(u.pm, u.pn, wr * 4 + wc, ai, m, bj) * 64 + fq * 16 + fr) * 8) = (u32x2){wl[0], wl[1]};
            }
            float ss = ss2.x + ss2.y;
            ss += __shfl_xor(ss, 16); ss += __shfl_xor(ss, 32);
            if (fq == 0) *GP(float, ssp + (size_t)(u.pn * 4 + wc) * TT + row) = ss;
        }
        asm volatile("" ::: "memory");
    }
    __device__ __forceinline__ void operator()(const AccT& acc, const Unit& u, int ui, int wr, int wc, int fr, int fq) const {
        if (MODE == 0) { round<4>(acc, u, 0, 0, wr, wc, fr, fq); round<4>(acc, u, 1, 0, wr, wc, fr, fq); }
        else { round<2>(acc, u, 0, 0, wr, wc, fr, fq); round<2>(acc, u, 0, 2, wr, wc, fr, fq); round<2>(acc, u, 1, 0, wr, wc, fr, fq); round<2>(acc, u, 1, 2, wr, wc, fr, fq); }
    }
};
struct EpiZ {
    bf16_t* Z; const LAS float* rs;
    __device__ __forceinline__ void operator()(const AccT& acc, const Unit& u, int ui, int wr, int wc, int fr, int fq) const {
#pragma unroll
        for (int ai = 0; ai < 2; ++ai)
#pragma unroll
            for (int m = 0; m < 4; ++m) {
                const int rl = ai * 128 + wr * 64 + m * 16 + fr; const float r = rs[((u.pm >> 3) & 3) * 256 + rl];
                bf16_t* p = Z + (size_t)(u.pm * 256 + rl) * DM + u.pn * 256 + wc * 32 + 8 * fq;
#pragma unroll
                for (int bj = 0; bj < 2; ++bj) { const f32x4 a0 = acc[ai][bj][m][0] * r, a1 = acc[ai][bj][m][1] * r;
                    u32x4 w; w.x = cvt_pk_bf16(a0[0], a0[1]); w.y = cvt_pk_bf16(a0[2], a0[3]); w.z = cvt_pk_bf16(a1[0], a1[1]); w.w = cvt_pk_bf16(a1[2], a1[3]);
                    *GP(u32x4, p + bj * 128) = w; }
            }
    }
};
struct EpiGLU {
    const bf16_t* Y; bf16_t* MIX;
    __device__ __forceinline__ void operator()(const AccT& acc, const Unit& u, int ui, int wr, int wc, int fr, int fq) const {
#pragma unroll
        for (int ai = 0; ai < 2; ++ai) {
            u32x4 yv[4][2];
#pragma unroll
            for (int m = 0; m < 4; ++m)
#pragma unroll
                for (int bj = 0; bj < 2; ++bj) yv[m][bj] = *GP(const u32x4, Y + (size_t)(u.pm * 256 + ai * 128 + wr * 64 + m * 16 + fr) * 512 + u.pn * 256 + bj * 128 + wc * 32 + 8 * fq);
#pragma unroll
            for (int m = 0; m < 4; ++m) {
                const int row = u.pm * 256 + ai * 128 + wr * 64 + m * 16 + fr;
#pragma unroll
                for (int bj = 0; bj < 2; ++bj) {
                    const int col = u.pn * 256 + bj * 128 + wc * 32 + 8 * fq;
                    const u32x4 y = yv[m][bj];
                    const f32x4 a0 = acc[ai][bj][m][0], a1 = acc[ai][bj][m][1];
                    u32x4 w;
                    w.x = cvt_pk_bf16(bflo(y.x) * fsigmoid(a0[0]), bfhi(y.x) * fsigmoid(a0[1]));
                    w.y = cvt_pk_bf16(bflo(y.y) * fsigmoid(a0[2]), bfhi(y.y) * fsigmoid(a0[3]));
                    w.z = cvt_pk_bf16(bflo(y.z) * fsigmoid(a1[0]), bfhi(y.z) * fsigmoid(a1[1]));
                    w.w = cvt_pk_bf16(bflo(y.w) * fsigmoid(a1[2]), bfhi(y.w) * fsigmoid(a1[3]));
                    *GP(u32x4, MIX + (size_t)row * DM + col) = w;
                }
            }
            asm volatile("" ::: "memory");
        }
    }
};
struct EpiProj {
    bf16_t* O;
    __device__ __forceinline__ void operator()(const AccT& acc, const Unit& u, int ui, int wr, int wc, int fr, int fq) const {
#pragma unroll
        for (int ai = 0; ai < 2; ++ai)
#pragma unroll
            for (int m = 0; m < 4; ++m) {
#pragma unroll
                for (int bj = 0; bj < 2; ++bj) {
                    const f32x4 a0 = acc[ai][bj][m][0], a1 = acc[ai][bj][m][1];
                    u32x4 w; w.x = cvt_pk_bf16(a0[0], a0[1]); w.y = cvt_pk_bf16(a0[2], a0[3]); w.z = cvt_pk_bf16(a1[0], a1[1]); w.w = cvt_pk_bf16(a1[2], a1[3]);
                    *GP(u32x4, O + (tn_slot(u.pm, u.pn, wr * 4 + wc, ai, m, bj) * 64 + fq * 16 + fr) * 8) = w;
                }
            }
    }
};

__device__ __forceinline__ void build_rs(LAS float* rs, const float* ssp) {
    int tid = threadIdx.x, c = blockIdx.x; asm volatile("" : "+v"(tid), "+s"(c));
#pragma unroll
    for (int e2 = 0; e2 < 2; ++e2) {
        const int e = tid + e2 * NTHREADS, slot = e >> 8, t = e & 255;
        const int pm = 32 * (c & 7) + 8 * slot + ((c >> 3) & 7); const int row = pm * 256 + t; float sacc = 0.f;
#pragma unroll
        for (int q = 0; q < 16; ++q) sacc += *GP(const float, ssp + (size_t)q * TT + row);
        rs[slot * 256 + t] = 1.0f / sqrtf(sacc * (1.0f / 1024.0f) + 1e-6f);
    }
    __syncthreads();
}

__device__ __forceinline__ void convT_tile(const float* src, int ldsrc, const float* sc, bf16_t* dst, int dstld, int k0, int n0, int swiglu, LAS float* t) {
    const int tid = threadIdx.x;
    { const int r = tid >> 6, c4 = (tid & 63) * 4;
      int ncol = n0 + c4; if (swiglu) { const int blk = n0 >> 8; ncol = (c4 < 128) ? (128 * blk + c4) : (FF + 128 * blk + (c4 - 128)); }
      f32x4 v[8]; float sv[8];
#pragma unroll
      for (int i = 0; i < 8; ++i) { const int rr = r + 8 * i; v[i] = *(const f32x4*)(src + (size_t)(k0 + rr) * ldsrc + ncol); sv[i] = sc ? sc[k0 + rr] : 1.0f; }
#pragma unroll
      for (int i = 0; i < 8; ++i) { const int rr = r + 8 * i; t[rr * 257 + c4 + 0] = v[i][0] * sv[i]; t[rr * 257 + c4 + 1] = v[i][1] * sv[i]; t[rr * 257 + c4 + 2] = v[i][2] * sv[i]; t[rr * 257 + c4 + 3] = v[i][3] * sv[i]; } }
    __syncthreads();
    { const int nn = tid >> 1, kh = (tid & 1) * 32;
#pragma unroll
      for (int q = 0; q < 4; ++q) { float v[8];
#pragma unroll
          for (int j = 0; j < 8; ++j) v[j] = t[(kh + q * 8 + j) * 257 + nn];
          u32x4 w; w.x = cvt_pk_bf16(v[0], v[1]); w.y = cvt_pk_bf16(v[2], v[3]); w.z = cvt_pk_bf16(v[4], v[5]); w.w = cvt_pk_bf16(v[6], v[7]);
          *(u32x4*)(dst + (size_t)(n0 + nn) * dstld + k0 + kh + q * 8) = w; } }
    __syncthreads();
}
__device__ __forceinline__ void convT(const float* src, int ldsrc, const float* sc, bf16_t* dst, int dstld, int Krows, int Ncols, int swiglu, LAS float* t, int& base) {
    const int G = gridDim.x, nkt = Krows / 64, ntiles = nkt * (Ncols / 256);
    int first = ((int)blockIdx.x - (base % G) + G) % G;
    for (int idx = first; idx < ntiles; idx += G) {
        const int kt = idx % nkt, ntile = idx / nkt;
        convT_tile(src, ldsrc, sc, dst, dstld, kt * 64, ntile * 256, swiglu, t);
    }
    base += ntiles;
}
__device__ __forceinline__ void conv_poolout(const float* pw, const float* pscale, const float* wout, bf16_t* dst, LAS float* t, int& base) {
    const int G = gridDim.x, tid = threadIdx.x, ntiles = 8 * 16;
    int first = ((int)blockIdx.x - (base % G) + G) % G;
    for (int idx = first; idx < ntiles; idx += G) {
        const int k0 = (idx & 7) * 64, n0 = (idx >> 3) * 64;
        const int tn = tid & 63, tk = tid >> 6; const int kb = k0 + tk * 8; const int gi = kb >> 7, kk0 = kb & 127;
        float a[8];
#pragma unroll
        for (int i = 0; i < 8; ++i) a[i] = 0.f;
        const float* pwg = pw + (size_t)gi * 128 * 128 + (size_t)kk0 * 128;
        for (int m = 0; m < 128; ++m) {
            const float w = wout[(size_t)(512 + gi * 128 + m) * DM + n0 + tn] * pscale[gi * 128 + m];
#pragma unroll
            for (int i = 0; i < 8; ++i) a[i] += pwg[i * 128 + m] * w;
        }
#pragma unroll
        for (int i = 0; i < 8; ++i) t[(tk * 8 + i) * 65 + tn] = a[i];
        __syncthreads();
        { const int nn = tid >> 3, k8 = (tid & 7) * 8; float v[8];
#pragma unroll
          for (int j = 0; j < 8; ++j) v[j] = t[(k8 + j) * 65 + nn];
          u32x4 w; w.x = cvt_pk_bf16(v[0], v[1]); w.y = cvt_pk_bf16(v[2], v[3]); w.z = cvt_pk_bf16(v[4], v[5]); w.w = cvt_pk_bf16(v[6], v[7]);
          *(u32x4*)(dst + (size_t)(n0 + nn) * DM + 512 + k0 + k8) = w; }
        __syncthreads();
    }
    base += ntiles;
}

__device__ __forceinline__ void dsincos(double th, double& s, double& c) {
    const double k = rint(th * 0.63661977236758134308);
    const double r = (th - k * 1.57079632679489655800) - k * 6.123233995736766e-17;
    const double r2 = r * r;
    const double sp = r * (1.0 + r2 * (-1.0 / 6 + r2 * (1.0 / 120 + r2 * (-1.0 / 5040 + r2 * (1.0 / 362880 + r2 * (-1.0 / 39916800 + r2 * (1.0 / 6227020800.0)))))));
    const double cp = 1.0 + r2 * (-0.5 + r2 * (1.0 / 24 + r2 * (-1.0 / 720 + r2 * (1.0 / 40320 + r2 * (-1.0 / 3628800 + r2 * (1.0 / 479001600.0 + r2 * (-1.0 / 87178291200.0)))))));
    const int q = ((int)k) & 3;
    s = (q == 0) ? sp : (q == 1) ? cp : (q == 2) ? -sp : -cp;
    c = (q == 0) ? cp : (q == 1) ? -sp : (q == 2) ? -cp : sp;
}

__device__ void prologue(const Params& P, LAS unsigned char* lds) {
    const int tid = threadIdx.x, lane = tid & 63, wave = tid >> 6, G = gridDim.x;
    unsigned char* ws = P.ws;
    {
        const float* x = P.in[0]; bf16_t* hb = (bf16_t*)(ws + WS_HB0); unsigned char* lo = ws + WS_LO; float* ssp = (float*)(ws + WS_SSP0);
        for (int row = blockIdx.x * 8 + wave; row < TT; row += G * 8) {
            float ss = 0.f;
#pragma unroll
            for (int q = 0; q < 4; ++q) { const f32x4 v = *(const f32x4*)(x + (size_t)row * DM + q * 256 + lane * 4);
                ss += (v[0] * v[0] + v[1] * v[1]) + (v[2] * v[2] + v[3] * v[3]);
                u32x2 w; w.x = cvt_pk_bf16(v[0], v[1]); w.y = cvt_pk_bf16(v[2], v[3]); *(u32x2*)(hb + (size_t)row * DM + q * 256 + lane * 4) = w;
                *(unsigned*)(lo + tn_index(row, q * 256 + lane * 4)) = lo_pack4(v[0] - bflo(w.x), v[1] - bfhi(w.x), v[2] - bflo(w.y), v[3] - bfhi(w.y)); }
#pragma unroll
            for (int o = 32; o >= 1; o >>= 1) ss += __shfl_xor(ss, o);
            if (lane < 16) ssp[(size_t)lane * TT + row] = (lane == 0) ? ss : 0.f;
        }
    }
    {
        LAS float* t = (LAS float*)lds; int base = 0;
        for (int l = 0; l < NLAYER; ++l) {
            bf16_t* W = (bf16_t*)(ws + WS_W) + (size_t)l * LW;
            convT(P.in[3] + (size_t)l * DM * 2 * FF, 2 * FF, P.in[2] + l * DM, W + W_WI1, DM, DM, 2 * FF, 1, t, base);
            convT(P.in[4] + (size_t)l * FF * DM, DM, nullptr, W + W_WO1, FF, FF, DM, 0, t, base);
            convT(P.in[6] + (size_t)l * DM * DM, DM, P.in[5] + l * DM, W + W_WIN, DM, DM, DM, 0, t, base);
            convT(P.in[15] + (size_t)l * 512 * 512, 512, nullptr, W + W_GLU, 512, 512, 512, 0, t, base);
            convT(P.in[18] + (size_t)l * DM * DM, DM, nullptr, W + W_OUT, DM, 512, DM, 0, t, base);
            conv_poolout(P.in[16] + (size_t)l * 4 * 128 * 128, P.in[17] + l * 512, P.in[18] + (size_t)l * DM * DM, W + W_OUT, t, base);
            convT(P.in[20] + (size_t)l * DM * 2 * FF, 2 * FF, P.in[19] + l * DM, W + W_WI2, DM, DM, 2 * FF, 1, t, base);
            convT(P.in[21] + (size_t)l * FF * DM, DM, nullptr, W + W_WO2, FF, FF, DM, 0, t, base);
            convT(P.in[23] + (size_t)l * DM * DM, DM, P.in[22] + l * DM, W + W_GATE, DM, DM, DM, 0, t, base);
            convT(P.in[24] + (size_t)l * 256 * DM, DM, nullptr, W + W_PLE, 256, 256, DM, 0, t, base);
        }
    }
    {
        const int gt = blockIdx.x * NTHREADS + tid, nthr = G * NTHREADS;
        for (int it = gt; it < NLAYER * 2048; it += nthr) {
            const int l = it >> 11, gp = it & 2047, g = gp >> 6;
            const double lr = P.in[7][it], li = P.in[8][it]; const double dt = (double)expf(P.in[9][l * 32 + g]);
            double sn, cs; dsincos(li * dt, sn, cs); const double mag = (double)expf((float)(lr * dt));
            const float ar = (float)(mag * cs), ai = (float)(mag * sn);
            unsigned char* sb = ws + WS_SSM + (size_t)l * SSM_LBYTES;
            ((float*)(sb + SSM_LAMB))[gp * 2] = ar; ((float*)(sb + SSM_LAMB))[gp * 2 + 1] = ai;
            double pr = ar, pi = ai;
#pragma unroll
            for (int s = 0; s < 10; ++s) { const double nr = pr * pr - pi * pi, ni = 2.0 * pr * pi; pr = nr; pi = ni; }
            ((float*)(sb + SSM_LAMB1K))[gp * 2] = (float)pr; ((float*)(sb + SSM_LAMB1K))[gp * 2 + 1] = (float)pi;
            const double nr = mag * cs - 1.0, ni = mag * sn, den = lr * lr + li * li;
            const double qr = (nr * lr + ni * li) / den, qi = (ni * lr - nr * li) / den;
            bf16_t* Bf = (bf16_t*)(sb + SSM_BFRAG) + (size_t)g * 8 * 64 * 4;
            const float* bre = P.in[10] + (size_t)it * 16; const float* bim = P.in[11] + (size_t)it * 16;
            const int p = gp & 63, tq = p >> 4, frr = p & 15;
#pragma unroll
            for (int hh = 0; hh < 16; ++hh) { const double br = bre[hh], bi = bim[hh]; const int ln = (hh >> 2) * 16 + frr, i = hh & 3;
                Bf[((size_t)tq * 64 + ln) * 4 + i] = f2bf((float)(qr * br - qi * bi)); Bf[((size_t)(tq + 4) * 64 + ln) * 4 + i] = f2bf((float)(qr * bi + qi * br)); }
        }
        for (int it = gt; it < NLAYER * 32 * 4 * 64 * 8; it += nthr) {
            const int i = it & 7, ln = (it >> 3) & 63, kt = (it >> 9) & 3, g = (it >> 11) & 31, l = it >> 16;
            const int hh = ln & 15, k = 32 * kt + 8 * (ln >> 4) + i, p = k >> 1;
            const size_t ci = (((size_t)l * 32 + g) * 16 + hh) * 64 + p;
            const float v = (k & 1) ? -P.in[13][ci] : P.in[12][ci];
            ((bf16_t*)(ws + WS_SSM + (size_t)l * SSM_LBYTES + SSM_CFRAG))[it & 65535] = f2bf(v);
        }
    }
}

__device__ __forceinline__ void conv_p(const Params& P, int l) {
    const float* src = P.in[1] + (size_t)l * TT * 256; bf16_t* dst = (bf16_t*)(P.ws + WS_PB);
    const size_t n8 = (size_t)TT * 256 / 8, stride = (size_t)gridDim.x * NTHREADS;
    size_t i = (size_t)blockIdx.x * NTHREADS + threadIdx.x;
    for (; i + 3 * stride < n8; i += 4 * stride) {
        f32x4 a[4], b[4];
#pragma unroll
        for (int q = 0; q < 4; ++q) { a[q] = *(const f32x4*)(src + (i + q * stride) * 8); b[q] = *(const f32x4*)(src + (i + q * stride) * 8 + 4); }
#pragma unroll
        for (int q = 0; q < 4; ++q) { u32x4 w; w.x = cvt_pk_bf16(a[q][0], a[q][1]); w.y = cvt_pk_bf16(a[q][2], a[q][3]); w.z = cvt_pk_bf16(b[q][0], b[q][1]); w.w = cvt_pk_bf16(b[q][2], b[q][3]);
            *(u32x4*)(dst + (i + q * stride) * 8) = w; }
    }
    for (; i < n8; i += stride) {
        const f32x4 a = *(const f32x4*)(src + i * 8), b = *(const f32x4*)(src + i * 8 + 4);
        u32x4 w; w.x = cvt_pk_bf16(a[0], a[1]); w.y = cvt_pk_bf16(a[2], a[3]); w.z = cvt_pk_bf16(b[0], b[1]); w.w = cvt_pk_bf16(b[2], b[3]);
        *(u32x4*)(dst + i * 8) = w;
    }
}

typedef short bf16x4 __attribute__((ext_vector_type(4)));
template <int PASS> __device__ void ssm_pass(const Params& P, int l, LAS unsigned char* lds) {
    int tid = threadIdx.x; asm volatile("" : "+v"(tid));
    const int lane = tid & 63, wave = __builtin_amdgcn_readfirstlane(tid >> 6), G = gridDim.x, fr = lane & 15, fq = lane >> 4;
    unsigned char* ws = P.ws;
    const bf16_t* z = (const bf16_t*)(ws + WS_BIG + BIG_Z); float* E = (float*)(ws + WS_BIG + BIG_E); bf16_t* ypre = (bf16_t*)(ws + WS_BIG + BIG_YPRE);
    const unsigned char* sb = ws + WS_SSM + (size_t)l * SSM_LBYTES;
    const float* lamb = (const float*)(sb + SSM_LAMB); const float* lamb1k = (const float*)(sb + SSM_LAMB1K);
    const bf16_t* Bfrag = (const bf16_t*)(sb + SSM_BFRAG); const bf16_t* Cfrag = (const bf16_t*)(sb + SSM_CFRAG); const float* dskip = P.in[14] + l * 512;
    LAS unsigned char* BU = lds + wave * 12800;
    LAS unsigned char* SI = BU + 8448;
    for (int unit = blockIdx.x; unit < 256; unit += G) {
        const int b = unit >> 4, r = (unit >> 2) & 3, g = (unit & 3) * 8 + wave;
        const size_t tok0 = (size_t)b * SEQ + r * 1024;
        const f32x2 a = *(const f32x2*)(lamb + (g * 64 + lane) * 2);
        bf16x4 bf[8];
#pragma unroll
        for (int t = 0; t < 8; ++t) bf[t] = *(const bf16x4*)(Bfrag + ((size_t)(g * 8 + t) * 64 + lane) * 4);
        float sr = 0.f, si = 0.f;
        bf16x8 cf[4]; f32x4 dd;
        if (PASS == 2) {
            const f32x2 a1k = *(const f32x2*)(lamb1k + (g * 64 + lane) * 2);
            for (int rr = 0; rr < r; ++rr) { const f32x2 e = *(const f32x2*)(E + ((size_t)((b * 32 + g) * 4 + rr) * 64 + lane) * 2);
                const float nr = a1k.x * sr - a1k.y * si + e.x, ni = a1k.x * si + a1k.y * sr + e.y; sr = nr; si = ni; }
#pragma unroll
            for (int kt = 0; kt < 4; ++kt) cf[kt] = *(const bf16x8*)(Cfrag + ((size_t)(g * 4 + kt) * 64 + lane) * 8);
            dd = *(const f32x4*)(dskip + g * 16 + 4 * fq);
        }
        f32x2 sv = {sr, si}; const f32x2 axx = {a.x, a.x}, ayn = {-a.y, a.y};
        const bf16_t* zrow = z + (tok0 + fr) * DM + g * 16 + 4 * fq;
        u32x2 ucur = *(const u32x2*)zrow;
#pragma nounroll
        for (int mt = 0; mt < 64; ++mt) {
            u32x2 unext = ucur; if (mt < 63) unext = *(const u32x2*)(zrow + (size_t)(mt + 1) * 16 * DM);
            const bf16x4 af = __builtin_bit_cast(bf16x4, ucur);
            f32x4 d[8];
#pragma unroll
            for (int t = 0; t < 8; ++t) d[t] = __builtin_amdgcn_mfma_f32_16x16x16bf16_1k(af, bf[t], (f32x4){0.f, 0.f, 0.f, 0.f}, 0, 0, 0);
#pragma unroll
            for (int tq = 0; tq < 4; ++tq)
#pragma unroll
                for (int j = 0; j < 4; ++j) *(LAS f32x2*)(BU + (4 * fq + j) * 528 + (16 * tq + fr) * 8) = (f32x2){d[tq][j], d[tq + 4][j]};
            asm volatile("s_waitcnt lgkmcnt(0)" ::: "memory");
#pragma unroll
            for (int j = 0; j < 16; ++j) {
                const f32x2 bu = *(const LAS f32x2*)(BU + j * 528 + lane * 8);
                sv = __builtin_elementwise_fma(ayn, __builtin_shufflevector(sv, sv, 1, 0), __builtin_elementwise_fma(axx, sv, bu));
                if (PASS == 2) *(LAS unsigned*)(SI + j * 272 + lane * 4) = cvt_pk_bf16(sv.x, sv.y);
            }
            if (PASS == 2) {
                asm volatile("s_waitcnt lgkmcnt(0)" ::: "memory");
                f32x4 acc = (f32x4){0.f, 0.f, 0.f, 0.f};
#pragma unroll
                for (int kt = 0; kt < 4; ++kt) { const bf16x8 sv = *(const LAS bf16x8*)(SI + fr * 272 + (32 * kt + 8 * fq) * 2);
                    acc = __builtin_amdgcn_mfma_f32_16x16x32_bf16(cf[kt], sv, acc, 0, 0, 0); }
                const size_t tok = tok0 + 16 * mt + fr;
                float o[4];
                const float uf[4] = {bflo(ucur.x), bfhi(ucur.x), bflo(ucur.y), bfhi(ucur.y)};
#pragma unroll
                for (int j = 0; j < 4; ++j) { const float y = acc[j] + dd[j] * uf[j]; o[j] = y * fsigmoid(1.5957691216057308f * (y + 0.044715f * y * y * y)); }
                u32x2 w; w.x = cvt_pk_bf16(o[0], o[1]); w.y = cvt_pk_bf16(o[2], o[3]);
                *(u32x2*)(ypre + tok * 512 + g * 16 + 4 * fq) = w;
            }
            asm volatile("" ::: "memory");
            ucur = unext;
        }
        if (PASS == 1) *(f32x2*)(E + ((size_t)((b * 32 + g) * 4 + r) * 64 + lane) * 2) = sv;
    }
}

__device__ __forceinline__ float bf2f(bf16_t v) { return __uint_as_float(((unsigned)v) << 16); }
template <int W> __device__ __forceinline__ void pool_round2(const bf16_t* zpa, bf16_t* mpa, const bf16_t* zpb, bf16_t* mpb, int t0) {
    float a[W - 1 + 16], c[W - 1 + 16];
#pragma unroll
    for (int i = 0; i < W - 1 + 16; ++i) { const int t = t0 - (W - 1) + i; a[i] = (t >= 0) ? bf2f(zpa[(size_t)t * DM]) : 0.f; c[i] = (t >= 0) ? bf2f(zpb[(size_t)t * DM]) : 0.f; }
    float sa = 0.f, sc = 0.f;
#pragma unroll
    for (int i = 0; i < W - 1; ++i) { sa += a[i]; sc += c[i]; }
#pragma unroll
    for (int j = 0; j < 16; ++j) {
        const int t = t0 + j; const float va = a[W - 1 + j], vc = c[W - 1 + j]; sa += va; sc += vc;
        const float inv = 1.0f / (float)((t + 1 < W) ? t + 1 : W);
        mpa[(size_t)t * DM] = f2bf(sa * inv - va); mpb[(size_t)t * DM] = f2bf(sc * inv - vc);
        sa -= a[j]; sc -= c[j];
    }
}
__device__ void pool_phase(const Params& P) {
    int tid = threadIdx.x; asm volatile("" : "+v"(tid));
    const int G = gridDim.x; unsigned char* ws = P.ws;
    const bf16_t* z = (const bf16_t*)(ws + WS_BIG + BIG_Z); bf16_t* mix = (bf16_t*)(ws + WS_BIG + BIG_MIX);
    const int ch = tid, gi = __builtin_amdgcn_readfirstlane(ch >> 7);
    for (int q = blockIdx.x; q < 2048; q += G) {
        const int t0 = (q & 255) * 16, b0 = (q >> 8) * 2;
        const bf16_t* zpa = z + (size_t)b0 * SEQ * DM + 512 + ch; bf16_t* mpa = mix + (size_t)b0 * SEQ * DM + 512 + ch;
        const bf16_t* zpb = zpa + (size_t)SEQ * DM; bf16_t* mpb = mpa + (size_t)SEQ * DM;
        if (gi == 0) pool_round2<2>(zpa, mpa, zpb, mpb, t0); else if (gi == 1) pool_round2<4>(zpa, mpa, zpb, mpb, t0); else if (gi == 2) pool_round2<8>(zpa, mpa, zpb, mpb, t0); else pool_round2<16>(zpa, mpa, zpb, mpb, t0);
    }
}

__device__ void final_norm(const Params& P, const float* ssp, const bf16_t* hi, const unsigned char* lo) {
    const int tid = threadIdx.x, lane = tid & 63, wave = tid >> 6, G = gridDim.x;
    float* out = P.out; const float* fn = P.in[25];
    f32x4 w[4];
#pragma unroll
    for (int q = 0; q < 4; ++q) w[q] = *(const f32x4*)(fn + q * 256 + lane * 4);
    for (int row = blockIdx.x * 8 + wave; row < TT; row += G * 8) {
        float ss = (lane < 16) ? ssp[(size_t)lane * TT + row] : 0.f;
        u32x2 hv[4]; unsigned lv[4];
#pragma unroll
        for (int q = 0; q < 4; ++q) { hv[q] = *(const u32x2*)(hi + (size_t)row * DM + q * 256 + lane * 4); lv[q] = *(const unsigned*)(lo + tn_index(row, q * 256 + lane * 4)); }
#pragma unroll
        for (int o = 32; o >= 1; o >>= 1) ss += __shfl_xor(ss, o);
        const float r = 1.0f / sqrtf(ss * (1.0f / 1024.0f) + 1e-6f);
#pragma unroll
        for (int q = 0; q < 4; ++q) { const f32x4 v = (f32x4){bflo(hv[q].x), bfhi(hv[q].x), bflo(hv[q].y), bfhi(hv[q].y)} + lo_unpack4(lv[q]);
            *(f32x4*)(out + (size_t)row * DM + q * 256 + lane * 4) = v * r * w[q]; }
    }
}

__global__ void __launch_bounds__(NTHREADS, 2) mega_fwd(Params P) {
    extern __shared__ __attribute__((aligned(16))) unsigned char lds_raw[];
    LAS unsigned char* lds = (LAS unsigned char*)lds_raw;
    LAS float* rs = (LAS float*)(lds + STAGE_LDS);
    cg::grid_group grid = cg::this_grid();
#ifndef PHMASK
#define PHMASK 0xFFFF
#endif
#define HBC(l) ((bf16_t*)(wsb + (((l) & 1) ? WS_HB1 : WS_HB0)))
#define HBN(l) ((bf16_t*)(wsb + (((l) & 1) ? WS_HB0 : WS_HB1)))
#define SSPC(l) ((float*)(wsb + (((l) & 1) ? WS_SSP1 : WS_SSP0)))
#define SSPN(l) ((float*)(wsb + (((l) & 1) ? WS_SSP0 : WS_SSP1)))
#define WL(l) ((const bf16_t*)(wsb + WS_W) + (size_t)(l) * LW)
#define BIGP(T_, off) ((T_*)(wsb + WS_BIG + (off)))
#define LOP ((unsigned char*)(wsb + WS_LO))
    volatile LAS unsigned* xbst = (volatile LAS unsigned*)(lds + LDS_BYTES - 16);
    if (threadIdx.x < 4) xbst[threadIdx.x] = 0u;
    __syncthreads();
    const XcdBarrier xbar = xcd_barrier_post((unsigned*)(P.ws + WS_BAR), xbst);
    if (PHMASK & 1) prologue(P, lds);
    grid.sync();

    for (int ph = 0; ph < NLAYER * 11; ++ph) {
        const int l = ph / 11, k = ph - l * 11;
#ifndef REPK
#define REPK -1
#define REPN 1
#endif
        for (int rep = 0; rep < ((k == REPK) ? REPN : 1); ++rep) {
        int G = gridDim.x, cid = blockIdx.x; unsigned char* wsb = P.ws; asm volatile("" : "+s"(G), "+s"(cid), "+s"(wsb));
        switch (k) {
        case 0: if (PHMASK & 2) {
            pg8::RevOrder S; S.init(TT, 2 * FF, G, cid); build_rs(rs, SSPC(l));
            pg8::Gemm g{HBC(l), WL(l) + W_WI1, TT, 2 * FF, DM}; EpiSwiGLU E{BIGP(bf16_t, BIG_HID), rs}; pg8::gemm_phase(lds, g, S, E); } break;
        case 1: if (PHMASK & 4) {
            pg8::StaticOrder S; S.init(TT, DM, G, cid);
            pg8::Gemm g{BIGP(bf16_t, BIG_HID), WL(l) + W_WO1, TT, DM, FF}; EpiH<0> E{HBC(l), HBC(l), LOP, SSPC(l), 0.5f, nullptr, rs}; pg8::gemm_phase(lds, g, S, E); } break;
        case 2: if (PHMASK & 8) {
            pg8::RevOrder S; S.init(TT, DM, G, cid); build_rs(rs, SSPC(l));
            pg8::Gemm g{HBC(l), WL(l) + W_WIN, TT, DM, DM}; EpiZ E{BIGP(bf16_t, BIG_Z), rs}; pg8::gemm_phase(lds, g, S, E); } break;
        case 3: if (PHMASK & 16) {
            ssm_pass<1>(P, l, lds); pool_phase(P); conv_p(P, l); } break;
        case 4: if (PHMASK & 32) {
            ssm_pass<2>(P, l, lds); } break;
        case 5: if (PHMASK & 64) {
            pg8::StaticOrder S; S.init(TT, 512, G, cid);
            pg8::Gemm g{BIGP(bf16_t, BIG_YPRE), WL(l) + W_GLU, TT, 512, 512}; EpiGLU E{BIGP(bf16_t, BIG_YPRE), BIGP(bf16_t, BIG_MIX)}; pg8::gemm_phase(lds, g, S, E); } break;
        case 6: if (PHMASK & 128) {
            pg8::RevOrder S; S.init(TT, DM, G, cid);
            pg8::Gemm g{BIGP(bf16_t, BIG_MIX), WL(l) + W_OUT, TT, DM, DM}; EpiH<0> E{HBC(l), HBC(l), LOP, SSPC(l), 1.0f, nullptr, rs}; pg8::gemm_phase(lds, g, S, E); } break;
        case 7: if (PHMASK & 256) {
            pg8::StaticOrder S; S.init(TT, 2 * FF, G, cid); build_rs(rs, SSPC(l));
            pg8::Gemm g{HBC(l), WL(l) + W_WI2, TT, 2 * FF, DM}; EpiSwiGLU E{BIGP(bf16_t, BIG_HID), rs}; pg8::gemm_phase(lds, g, S, E); } break;
        case 8: if (PHMASK & 512) {
            pg8::RevOrder S; S.init(TT, DM, G, cid);
            pg8::Gemm g{BIGP(bf16_t, BIG_HID), WL(l) + W_WO2, TT, DM, FF}; EpiH<0> E{HBC(l), HBC(l), LOP, SSPC(l), 0.5f, nullptr, rs}; pg8::gemm_phase(lds, g, S, E); } break;
        case 9: if (PHMASK & 1024) {
            pg8::StaticOrder S; S.init(TT, DM, G, cid); build_rs(rs, SSPC(l));
            pg8::Gemm g{(const bf16_t*)(wsb + WS_PB), WL(l) + W_PLE, TT, DM, 256}; EpiProj E{BIGP(bf16_t, BIG_PROJ)}; pg8::gemm_phase(lds, g, S, E); } break;
        default: if (PHMASK & 1024) {
            pg8::StaticOrder S; S.init(TT, DM, G, cid);
            pg8::Gemm g{HBC(l), WL(l) + W_GATE, TT, DM, DM}; EpiH<1> E{HBC(l), HBN(l), LOP, SSPN(l), 1.0f, BIGP(bf16_t, BIG_PROJ), rs}; pg8::gemm_phase(lds, g, S, E); } break;
        }
        if (k != 9) xcd_barrier(xbar);
        }
    }
    if (PHMASK & 0x800) final_norm(P, (const float*)(P.ws + ((NLAYER & 1) ? WS_SSP1 : WS_SSP0)), (const bf16_t*)(P.ws + ((NLAYER & 1) ? WS_HB1 : WS_HB0)), (const unsigned char*)(P.ws + WS_LO));
}

extern "C" void kernel_launch(void* const* d_in, const int* in_sizes, int n_in, void* d_out, int out_size, void* d_ws, size_t ws_size, hipStream_t stream) {
    static int grid_blocks = 0;
    if (!grid_blocks) {
        int dev = 0, cus = 0, per_cu = 0;
        hipGetDevice(&dev);
        hipDeviceGetAttribute(&cus, hipDeviceAttributeMultiprocessorCount, dev);
        if (hipFuncSetAttribute((const void*)mega_fwd, hipFuncAttributeMaxDynamicSharedMemorySize, LDS_BYTES) != hipSuccess) fprintf(stderr, "hipFuncSetAttribute failed\n");
        if (hipOccupancyMaxActiveBlocksPerMultiprocessor(&per_cu, (const void*)mega_fwd, NTHREADS, LDS_BYTES) != hipSuccess || per_cu < 1) { per_cu = 1; (void)hipGetLastError(); }
        grid_blocks = cus * 1;
        if (ws_size < WS_END) fprintf(stderr, "workspace too small: %zu < %zu\n", ws_size, (size_t)WS_END);
    }
    Params p{};
    for (int i = 0; i < 26; ++i) p.in[i] = (const float*)d_in[i];
    p.out = (float*)d_out; p.ws = (unsigned char*)d_ws;
    if (hipMemsetAsync((char*)d_ws + WS_BAR, 0, 16384, stream) != hipSuccess) fprintf(stderr, "memset of barrier words failed\n");
    void* args[] = {&p};
    hipError_t e = hipLaunchCooperativeKernel((void*)mega_fwd, dim3(grid_blocks), dim3(NTHREADS), args, LDS_BYTES, stream);
    if (e != hipSuccess) fprintf(stderr, "cooperative launch failed: %s (grid %d)\n", hipGetErrorString(e), grid_blocks);
}
```

```cpp
#include <hip/hip_runtime.h>
#include <hip/hip_cooperative_groups.h>
#include <cstdio>
namespace cg = cooperative_groups;

#define LAS __attribute__((address_space(3)))
typedef unsigned short bf16_t;
typedef short bf16x8 __attribute__((ext_vector_type(8)));
typedef float f32x4 __attribute__((ext_vector_type(4)));
typedef float f32x2 __attribute__((ext_vector_type(2)));
typedef unsigned u32x4 __attribute__((ext_vector_type(4)));
typedef unsigned u32x2 __attribute__((ext_vector_type(2)));

constexpr int TT = 65536;
constexpr int SEQ = 4096;
constexpr int DM = 1024;
constexpr int FF = 2816;
constexpr int NLAYER = 4;
constexpr int NTHREADS = 512;
constexpr int STAGE_LDS = 131072;
constexpr int RS_LDS = 24576;
constexpr int LDS_BYTES = STAGE_LDS + RS_LDS;

constexpr size_t WS_HB0 = 0;
constexpr size_t WS_HB1 = 134217728ull;
constexpr size_t WS_BIG = 268435456ull;
constexpr size_t BIG_HID = 0, BIG_Z = 0, BIG_PROJ = 0, BIG_MIX = 134217728ull, BIG_YPRE = 268435456ull, BIG_E = 335544320ull;
constexpr size_t BIG_SIZE = 369098752ull;
constexpr size_t WS_PB = WS_BIG + BIG_SIZE;
constexpr size_t WS_W = WS_PB + 33554432ull;
constexpr size_t LW = 20971520ull;
constexpr size_t W_WI1 = 0, W_WO1 = 5767168, W_WIN = 8650752, W_GLU = 9699328, W_OUT = 9961472, W_WI2 = 11010048, W_WO2 = 16777216, W_GATE = 19660800, W_PLE = 20709376;
constexpr size_t WS_SSP0 = WS_W + LW * 2 * NLAYER;
constexpr size_t WS_SSP1 = WS_SSP0 + 4194304ull;
constexpr size_t WS_SSM = WS_SSP1 + 4194304ull;
constexpr size_t SSM_LAMB = 0, SSM_LAMB1K = 16384, SSM_BFRAG = 32768, SSM_CFRAG = 32768 + 131072, SSM_LBYTES = 32768 + 131072 + 131072;
constexpr size_t WS_BAR = WS_SSM + SSM_LBYTES * NLAYER;
constexpr size_t WS_LO = WS_BAR + 16384;
constexpr size_t WS_END = WS_LO + 134217728ull;

struct Params { const float* in[26]; float* out; unsigned char* ws; };
#define GAS __attribute__((address_space(1)))
#define GP(T_, p) ((GAS T_*)(p))

typedef __bf16 bfx2_t __attribute__((ext_vector_type(2)));
__device__ __forceinline__ unsigned cvt_pk_bf16(float lo, float hi) { const f32x2 v = {lo, hi}; return __builtin_bit_cast(unsigned, __builtin_convertvector(v, bfx2_t)); }
__device__ __forceinline__ bf16_t f2bf(float f) { unsigned u = __float_as_uint(f); u += 0x7FFFu + ((u >> 16) & 1u); return (bf16_t)(u >> 16); }
__device__ __forceinline__ float bflo(unsigned w) { return __uint_as_float(w << 16); }
__device__ __forceinline__ float bfhi(unsigned w) { return __uint_as_float(w & 0xffff0000u); }
__device__ __forceinline__ unsigned lo_pack4(float a, float b, float c, float d) { int p = __builtin_amdgcn_cvt_pk_fp8_f32(a * 512.0f, b * 512.0f, 0, false); return (unsigned)__builtin_amdgcn_cvt_pk_fp8_f32(c * 512.0f, d * 512.0f, p, true); }
__device__ __forceinline__ f32x4 lo_unpack4(unsigned w) { const f32x2 a = __builtin_amdgcn_cvt_pk_f32_fp8((int)w, false), b = __builtin_amdgcn_cvt_pk_f32_fp8((int)w, true); return (f32x4){a.x, a.y, b.x, b.y} * (1.0f / 512.0f); }
__device__ __forceinline__ float fsigmoid(float x) { return __builtin_amdgcn_rcpf(1.0f + __builtin_amdgcn_exp2f(-1.4426950408889634f * x)); }


#define XB_TMO      128
#define XB_XCNT(j)  (256  + 64 * (j))
#define XB_XSUB(j)  (1280 + 64 * (j))
#define XB_XGEN(j)  (2304 + 64 * (j))
#define XB_TOP      3328
#define XB_TOPGEN   3392
#define XCD_BAR_WORDS 3456
#define XB_SPIN_CAP (1u << 18)
__device__ __forceinline__ unsigned xb_ld(unsigned* p)              { return __hip_atomic_load(p, __ATOMIC_RELAXED, __HIP_MEMORY_SCOPE_AGENT); }
__device__ __forceinline__ unsigned xb_add(unsigned* p, unsigned v) { return __hip_atomic_fetch_add(p, v, __ATOMIC_RELAXED, __HIP_MEMORY_SCOPE_AGENT); }
__device__ __forceinline__ unsigned xb_xcc_id() { return (unsigned)__builtin_amdgcn_s_getreg((3 << 11) | 20) & 0xFu; }
#define XB_SPIN(cond, bar) do { unsigned _sp = 0; while (cond) { __builtin_amdgcn_s_sleep(1); \
    if ((++_sp & 255u) == 0u) { if (xb_ld(&(bar)[XB_TMO])) break; if (_sp > XB_SPIN_CAP) { atomicAdd(&(bar)[XB_TMO], 1u); break; } } } } while (0)
struct XcdBarrier { unsigned* bar; unsigned x; volatile LAS unsigned* st; };
__device__ __forceinline__ XcdBarrier xcd_barrier_post(unsigned* bar, volatile LAS unsigned* st) {
    XcdBarrier b; b.bar = bar; b.x = xb_xcc_id(); b.st = st;
    if (threadIdx.x == 0) (void)xb_add(&bar[XB_XCNT(b.x)], 1u);
    return b;
}
__device__ __forceinline__ void xcd_barrier_complete(unsigned* bar, unsigned x, unsigned& nloc, unsigned& nx) {
    const unsigned G = gridDim.x * gridDim.y * gridDim.z;
    unsigned sum, cnt, mine, sp = 0u;
    for (;;) {
        sum = 0u; cnt = 0u; mine = 0u;
#pragma unroll
        for (unsigned j = 0; j < 16; ++j) { const unsigned c = xb_ld(&bar[XB_XCNT(j)]); sum += c; cnt += (c > 0u) ? 1u : 0u; mine = (j == x) ? c : mine; }
        if (sum == G) break;
        __builtin_amdgcn_s_sleep(1);
        if ((++sp & 255u) == 0u) { if (xb_ld(&bar[XB_TMO])) break; if (sp > XB_SPIN_CAP) { atomicAdd(&bar[XB_TMO], 1u); break; } }
    }
    nloc = mine > 0u ? mine : 1u; nx = cnt > 0u ? cnt : 1u;
}
__device__ __forceinline__ void xcd_barrier(const XcdBarrier& b) {
    asm volatile("s_waitcnt vmcnt(0)" ::: "memory");
    __syncthreads();
    if (threadIdx.x == 0) {
        unsigned* bar = b.bar;
        __builtin_amdgcn_s_waitcnt(0);
        unsigned nloc = b.st[0], nx = b.st[1];
        if (nloc == 0u) { xcd_barrier_complete(bar, b.x, nloc, nx); b.st[0] = nloc; b.st[1] = nx; }
        const unsigned old = xb_add(&bar[XB_XSUB(b.x)], 1u);
        const unsigned gen = old / nloc;
        if (old + 1u == (gen + 1u) * nloc) {
            __builtin_amdgcn_fence(__ATOMIC_RELEASE, "agent");
            asm volatile("s_waitcnt vmcnt(0)" ::: "memory");
            const unsigned og = xb_add(&bar[XB_TOP], 1u);
            const unsigned tg = og / nx;
            if (og + 1u == (tg + 1u) * nx) xb_add(&bar[XB_TOPGEN], 1u);
            else XB_SPIN(xb_ld(&bar[XB_TOPGEN]) == tg, bar);
            __builtin_amdgcn_fence(__ATOMIC_ACQUIRE, "agent");
            xb_add(&bar[XB_XGEN(b.x)], 1u);
            asm volatile("s_waitcnt vmcnt(0)" ::: "memory");
        } else {
            XB_SPIN(xb_ld(&bar[XB_XGEN(b.x)]) == gen, bar);
            __builtin_amdgcn_fence(__ATOMIC_ACQUIRE, "agent");
            asm volatile("s_waitcnt vmcnt(0)" ::: "memory");
        }
    }
    __syncthreads();
}

namespace pg8 {
constexpr int BM = 256, BK = 64, HALF = 128, HTB = HALF * BK * 2, NXCD = 8, WGM = 8;
__device__ __forceinline__ int lds_byte(int r, int c) { const int st = (r >> 4) * 2 + (c >> 5), rr = r & 15, cc = c & 31, ob = rr * 64 + cc * 2; return st * 1024 + (ob ^ (((ob >> 9) & 1) << 5)); }
__device__ __forceinline__ void stage_rc(int b, int& R, int& C) { const int st = b / 1024, sb = b % 1024, swz = sb ^ (((sb >> 9) & 1) << 5); R = (st >> 1) * 16 + swz / 64; C = (st & 1) * 32 + (swz % 64) / 2; }
__device__ __forceinline__ int perm32(int rho) { const int n = rho >> 4, i = rho & 15; return 8 * (i >> 2) + 4 * n + (i & 3); }
struct Unit { int pm, pn; };
struct Gemm { const bf16_t* A; const bf16_t* Bt; int M, N, K; };
struct StaticOrder {
    int nM, nN, nwg, G, c;
    __device__ void init(int M, int N, int G_, int c_) { nM = M / BM; nN = N / BM; nwg = nM * nN; G = G_; c = c_; }
    __device__ bool next(int i, Unit& u) const {
        const long L = (long)i * G + c; if (L >= nwg) return false;
        int wgid = (int)L; { const int q = nwg / NXCD, r = nwg % NXCD, xcd = wgid % NXCD, off = wgid / NXCD; wgid = (xcd < r ? xcd * (q + 1) : r * (q + 1) + (xcd - r) * q) + off; }
        const int nig = WGM * nN, gid = wgid / nig, fm = gid * WGM, gsz = (nM - fm) < WGM ? (nM - fm) : WGM;
        u.pm = fm + ((wgid % nig) % gsz); u.pn = (wgid % nig) / gsz; return true;
    }
};
struct RevOrder : StaticOrder { __device__ bool next(int i, Unit& u) const { const int nr = (nwg + G - 1) / G; if (i < 0 || i >= nr) return false; return StaticOrder::next(nr - 1 - i, u); } };
template <class Epi, class Ord>
__device__ __forceinline__ void gemm_phase(LAS unsigned char* lds, const Gemm g, const Ord& S, const Epi& E) {
    int tid = threadIdx.x; asm volatile("" : "+v"(tid));
    const int wid = __builtin_amdgcn_readfirstlane(tid >> 6), lane = tid & 63, wr = wid >> 2, wc = wid & 3, fr = lane & 15, fq = lane >> 4;
    int K = g.K; asm volatile("" : "+s"(K));
    const int nt = K / BK;
    unsigned voffA[2], voffB[2];
#pragma unroll
    for (int i = 0; i < 2; ++i) { int R, C; stage_rc(tid * 16 + i * 8192, R, C); const int Rb = (R & ~31) + perm32(R & 31);
        voffA[i] = (unsigned)(R * K + C) * 2u; voffB[i] = (unsigned)(Rb * K + C) * 2u; }
    const size_t kstep = (size_t)(BK * 2);
    const size_t hstep = (size_t)HALF * K * 2;
    const size_t tstep = 2 * hstep;
    const unsigned ldsw = (unsigned)wid * 1024u;
    const int aoff = lds_byte(wr * 64 + fr, fq * 8), boff = lds_byte(wc * 32 + fr, fq * 8);
#define PG8_SA(b, h) (((b) * 2 + (h)) * HTB)
#define PG8_SB(b, h) ((4 + (b) * 2 + (h)) * HTB)
#define PG8_STAGE(bufoff, gbase, voff) do { const char* _gb = (const char*)(gbase); asm volatile("" : "+s"(_gb)); _Pragma("unroll") for (int _i = 0; _i < 2; ++_i) { unsigned _vo = (voff)[_i]; asm volatile("" : "+v"(_vo)); \
        __builtin_amdgcn_global_load_lds((const GAS unsigned*)(_gb + _vo), (LAS unsigned*)(lds + (bufoff) + ldsw + _i * 8192), 16, 0, 0); } } while (0)
#define PG8_LDA(dst, b, h) do { _Pragma("unroll") for (int m = 0; m < 4; ++m) _Pragma("unroll") for (int k = 0; k < 2; ++k) dst[m][k] = *(const LAS bf16x8*)(lds + PG8_SA(b, h) + aoff + m * 2048 + k * 1024); } while (0)
#define PG8_LDB(dst, b, h) do { _Pragma("unroll") for (int n = 0; n < 2; ++n) _Pragma("unroll") for (int k = 0; k < 2; ++k) dst[n][k] = *(const LAS bf16x8*)(lds + PG8_SB(b, h) + boff + n * 2048 + k * 1024); } while (0)
#define PG8_MMA(ai, bj, At, Bt) do { __builtin_amdgcn_s_setprio(1); _Pragma("unroll") for (int m = 0; m < 4; ++m) _Pragma("unroll") for (int n = 0; n < 2; ++n) _Pragma("unroll") for (int k = 0; k < 2; ++k) \
        acc[ai][bj][m][n] = __builtin_amdgcn_mfma_f32_16x16x32_bf16(Bt[n][k], At[m][k], acc[ai][bj][m][n], 0, 0, 0); __builtin_amdgcn_s_setprio(0); } while (0)
#define PG8_WAIT_V(n) asm volatile("s_waitcnt vmcnt(" #n ")" ::: "memory")
#define PG8_WAIT_L(n) asm volatile("s_waitcnt lgkmcnt(" #n ")" ::: "memory")
#define PG8_BAR __builtin_amdgcn_s_barrier()
#define PG8_SCHED __builtin_amdgcn_sched_barrier(0)
    Unit cur, nxt; int ui = 0;
    if (!S.next(0, cur)) return;
    f32x4 acc[2][2][4][2];
#pragma unroll
    for (int a = 0; a < 2; ++a)
#pragma unroll
        for (int b = 0; b < 2; ++b)
#pragma unroll
            for (int m = 0; m < 4; ++m)
#pragma unroll
                for (int n = 0; n < 2; ++n) acc[a][b][m][n] = (f32x4){0.f, 0.f, 0.f, 0.f};
    bf16x8 At[4][2], B0[2][2], B1[2][2];
    const char* cA = (const char*)g.A + (size_t)cur.pm * tstep; const char* cB = (const char*)g.Bt + (size_t)cur.pn * tstep;
    PG8_STAGE(PG8_SB(0, 0), cB, voffB); PG8_STAGE(PG8_SA(0, 0), cA, voffA); PG8_STAGE(PG8_SB(0, 1), cB + hstep, voffB); PG8_STAGE(PG8_SA(0, 1), cA + hstep, voffA);
    if (wr == 1) PG8_BAR;
    PG8_WAIT_V(4); PG8_BAR;
    PG8_STAGE(PG8_SB(1, 0), cB + kstep, voffB); PG8_STAGE(PG8_SA(1, 0), cA + kstep, voffA); PG8_STAGE(PG8_SB(1, 1), cB + hstep + kstep, voffB);
    PG8_WAIT_V(6); PG8_BAR;
    for (;;) {
        const bool has_next = S.next(ui + 1, nxt);
        const char* nA = has_next ? (const char*)g.A + (size_t)nxt.pm * tstep : cA; const char* nB = has_next ? (const char*)g.Bt + (size_t)nxt.pn * tstep : cB;
#pragma nounroll
        for (int t = 0; t < nt; t += 2) {
            const bool last = (t == nt - 2);
            const char* a1 = cA + (size_t)(t + 1) * kstep;
            const char* a2 = last ? nA : cA + (size_t)(t + 2) * kstep; const char* b2 = last ? nB : cB + (size_t)(t + 2) * kstep;
            const char* a3 = a2 + kstep; const char* b3 = b2 + kstep;
            PG8_LDB(B0, 0, 0); PG8_SCHED; PG8_LDA(At, 0, 0); PG8_STAGE(PG8_SA(1, 1), a1 + hstep, voffA);
            PG8_WAIT_L(8); PG8_BAR; PG8_WAIT_L(0); PG8_MMA(0, 0, At, B0); PG8_BAR; PG8_SCHED;
            PG8_LDB(B1, 0, 1); PG8_STAGE(PG8_SB(0, 0), b2, voffB);
            PG8_BAR; PG8_WAIT_L(0); PG8_MMA(0, 1, At, B1); PG8_BAR;
            PG8_LDA(At, 0, 1); PG8_STAGE(PG8_SA(0, 0), a2, voffA);
            PG8_BAR; PG8_WAIT_L(0); PG8_MMA(1, 0, At, B0); PG8_BAR; PG8_SCHED;
            PG8_STAGE(PG8_SB(0, 1), b2 + hstep, voffB);
            PG8_WAIT_V(6); PG8_BAR; PG8_MMA(1, 1, At, B1); PG8_BAR;
            PG8_LDB(B0, 1, 0); PG8_SCHED; PG8_LDA(At, 1, 0); PG8_STAGE(PG8_SA(0, 1), a2 + hstep, voffA);
            PG8_WAIT_L(8); PG8_BAR; PG8_WAIT_L(0); PG8_MMA(0, 0, At, B0); PG8_BAR; PG8_SCHED;
            PG8_LDB(B1, 1, 1); PG8_STAGE(PG8_SB(1, 0), b3, voffB);
            PG8_BAR; PG8_WAIT_L(0); PG8_MMA(0, 1, At, B1); PG8_BAR;
            PG8_LDA(At, 1, 1); PG8_STAGE(PG8_SA(1, 0), a3, voffA);
            PG8_BAR; PG8_WAIT_L(0); PG8_MMA(1, 0, At, B0); PG8_BAR; PG8_SCHED;
            PG8_STAGE(PG8_SB(1, 1), b3 + hstep, voffB);
            PG8_WAIT_V(6); PG8_BAR; PG8_MMA(1, 1, At, B1); PG8_BAR;
        }
        E(acc, cur, ui, wr, wc, fr, fq);
        if (!has_next) break;
#pragma unroll
        for (int a = 0; a < 2; ++a)
#pragma unroll
            for (int b = 0; b < 2; ++b)
#pragma unroll
                for (int m = 0; m < 4; ++m)
#pragma unroll
                    for (int n = 0; n < 2; ++n) acc[a][b][m][n] = (f32x4){0.f, 0.f, 0.f, 0.f};
        cur = nxt; cA = nA; cB = nB; ++ui;
    }
    PG8_WAIT_V(0);
    if (wr == 0) PG8_BAR;
    PG8_BAR;
#undef PG8_SA
#undef PG8_SB
#undef PG8_STAGE
#undef PG8_LDA
#undef PG8_LDB
#undef PG8_MMA
#undef PG8_WAIT_V
#undef PG8_WAIT_L
#undef PG8_BAR
#undef PG8_SCHED
}
}
using pg8::Unit;
typedef f32x4 AccT[2][2][4][2];

__device__ __forceinline__ size_t tn_slot(int pm, int pn, int wave, int ai, int m, int bj) { return ((size_t)((pm * 4 + pn) * 8 + wave) * 16 + (ai * 4 + m) * 2 + bj); }
__device__ __forceinline__ size_t tn_index(int row, int col) {
    const int pm = row >> 8, rl = row & 255, pn = col >> 8, cl = col & 255;
    const int ai = rl >> 7, wr = (rl >> 6) & 1, m = (rl >> 4) & 3, fr = rl & 15, bj = cl >> 7, wc = (cl >> 5) & 3, fq = (cl >> 3) & 3, e = cl & 7;
    return (tn_slot(pm, pn, wr * 4 + wc, ai, m, bj) * 64 + fq * 16 + fr) * 8 + e;
}
struct EpiSwiGLU {
    bf16_t* O; const LAS float* rs;
    __device__ __forceinline__ void operator()(const AccT& acc, const Unit& u, int ui, int wr, int wc, int fr, int fq) const {
        const int col = u.pn * 128 + wc * 32 + 8 * fq;
#pragma unroll
        for (int ai = 0; ai < 2; ++ai)
#pragma unroll
            for (int m = 0; m < 4; ++m) {
                const int rl = ai * 128 + wr * 64 + m * 16 + fr; const float r = rs[((u.pm >> 3) & 3) * 256 + rl];
                const float nr = -1.4426950408889634f * r, r2 = r * r;
                unsigned w[4];
#pragma unroll
                for (int n = 0; n < 2; ++n)
#pragma unroll
                    for (int hlf = 0; hlf < 2; ++hlf) {
                        const f32x2 a = {acc[ai][0][m][n][2 * hlf], acc[ai][0][m][n][2 * hlf + 1]}, b = {acc[ai][1][m][n][2 * hlf], acc[ai][1][m][n][2 * hlf + 1]};
                        const f32x2 t = a * nr;
                        f32x2 d; d.x = __builtin_amdgcn_exp2f(t.x); d.y = __builtin_amdgcn_exp2f(t.y); d = d + 1.0f;
                        f32x2 q; q.x = __builtin_amdgcn_rcpf(d.x); q.y = __builtin_amdgcn_rcpf(d.y);
                        const f32x2 o = ((a * b) * r2) * q;
                        w[n * 2 + hlf] = cvt_pk_bf16(o.x, o.y);
                    }
                u32x4 wv; wv.x = w[0]; wv.y = w[1]; wv.z = w[2]; wv.w = w[3];
                *GP(u32x4, O + (size_t)(u.pm * 256 + rl) * FF + col) = wv;
            }
    }
};
template <int MODE> struct EpiH {
    const bf16_t* hin; bf16_t* hout; unsigned char* lo; float* ssp; float alpha; const bf16_t* proj; const LAS float* rs;
    template <int NM> __device__ __forceinline__ void round(const AccT& acc, const Unit& u, int ai, int m0, int wr, int wc, int fr, int fq) const {
        u32x4 hv[NM][2], pv[NM][2]; u32x2 lv[NM][2];
#pragma unroll
        for (int mm = 0; mm < NM; ++mm) {
            const int rl = ai * 128 + wr * 64 + (m0 + mm) * 16 + fr;
            const size_t off = (size_t)(u.pm * 256 + rl) * DM + u.pn * 256 + wc * 32 + 8 * fq;
#pragma unroll
            for (int bj = 0; bj < 2; ++bj) {
                const size_t tn = (tn_slot(u.pm, u.pn, wr * 4 + wc, ai, m0 + mm, bj) * 64 + fq * 16 + fr) * 8;
                hv[mm][bj] = *GP(const u32x4, hin + off + bj * 128); lv[mm][bj] = *GP(const u32x2, lo + tn);
                if (MODE == 1) pv[mm][bj] = *GP(const u32x4, proj + tn);
            }
        }
#pragma unroll
        for (int mm = 0; mm < NM; ++mm) {
            const int m = m0 + mm;
            const int rl = ai * 128 + wr * 64 + m * 16 + fr; const int row = u.pm * 256 + rl;
            const size_t off = (size_t)row * DM + u.pn * 256 + wc * 32 + 8 * fq;
            float r = 1.f; if (MODE == 1) r = rs[((u.pm >> 3) & 3) * 256 + rl];
            f32x2 ss2 = {0.f, 0.f};
#pragma unroll
            for (int bj = 0; bj < 2; ++bj) {
                const u32x4 H = hv[mm][bj]; const u32x2 L = lv[mm][bj];
                unsigned wh[4], wl[2] = {0u, 0u};
#pragma unroll
                for (int p = 0; p < 4; ++p) {
                    const unsigned hw = (p == 0) ? H.x : (p == 1) ? H.y : (p == 2) ? H.z : H.w;
                    const f32x2 a2 = {acc[ai][bj][m][p >> 1][2 * (p & 1)], acc[ai][bj][m][p >> 1][2 * (p & 1) + 1]};
                    f32x2 d;
                    if (MODE == 0) d = a2 * alpha;
                    else { const unsigned pw = (p == 0) ? pv[mm][bj].x : (p == 1) ? pv[mm][bj].y : (p == 2) ? pv[mm][bj].z : pv[mm][bj].w;
                        const f32x2 t = a2 * (-1.4426950408889634f * r);
                        f32x2 e; e.x = __builtin_amdgcn_exp2f(t.x); e.y = __builtin_amdgcn_exp2f(t.y); e = e + 1.0f;
                        f32x2 q; q.x = __builtin_amdgcn_rcpf(e.x); q.y = __builtin_amdgcn_rcpf(e.y);
                        d = q * (f32x2){bflo(pw), bfhi(pw)}; }
                    const f32x2 h2 = {bflo(hw), bfhi(hw)};
                    const int lw = (int)((p < 2) ? L.x : L.y);
                    const f32x2 l2 = (p & 1) ? __builtin_amdgcn_cvt_pk_f32_fp8(lw, true) : __builtin_amdgcn_cvt_pk_f32_fp8(lw, false);
                    const f32x2 o = __builtin_elementwise_fma(l2, (f32x2){1.0f / 512.0f, 1.0f / 512.0f}, h2 + d);
                    const unsigned w = cvt_pk_bf16(o.x, o.y); wh[p] = w;
                    const f32x2 rem = (o - (f32x2){bflo(w), bfhi(w)}) * 512.0f;
                    wl[p >> 1] = (p & 1) ? (unsigned)__builtin_amdgcn_cvt_pk_fp8_f32(rem.x, rem.y, (int)wl[p >> 1], true) : (unsigned)__builtin_amdgcn_cvt_pk_fp8_f32(rem.x, rem.y, (int)wl[p >> 1], false);
                    ss2 = __builtin_elementwise_fma(o, o, ss2);
                }
                *GP(u32x4, hout + off + bj * 128) = (u32x4){wh[0], wh[1], wh[2], wh[3]}; *GP(u32x2, lo + (tn_slot(u.pm, u.pn, wr * 4 + wc, ai, m, bj) * 64 + fq * 16 + fr) * 8) = (u32x2){wl[0], wl[1]};
            }
            float ss = ss2.x + ss2.y;
            ss += __shfl_xor(ss, 16); ss += __shfl_xor(ss, 32);
            if (fq == 0) *GP(float, ssp + (size_t)(u.pn * 4 + wc) * TT + row) = ss;
        }
        asm volatile("" ::: "memory");
    }
    __device__ __forceinline__ void operator()(const AccT& acc, const Unit& u, int ui, int wr, int wc, int fr, int fq) const {
        if (MODE == 0) { round<4>(acc, u, 0, 0, wr, wc, fr, fq); round<4>(acc, u, 1, 0, wr, wc, fr, fq); }
        else { round<2>(acc, u, 0, 0, wr, wc, fr, fq); round<2>(acc, u, 0, 2, wr, wc, fr, fq); round<2>(acc, u, 1, 0, wr, wc, fr, fq); round<2>(acc, u, 1, 2, wr, wc, fr, fq); }
    }
};
struct EpiZ {
    bf16_t* Z; const LAS float* rs;
    __device__ __forceinline__ void operator()(const AccT& acc, const Unit& u, int ui, int wr, int wc, int fr, int fq) const {
#pragma unroll
        for (int ai = 0; ai < 2; ++ai)
#pragma unroll
            for (int m = 0; m < 4; ++m) {
                const int rl = ai * 128 + wr * 64 + m * 16 + fr; const float r = rs[((u.pm >> 3) & 3) * 256 + rl];
                bf16_t* p = Z + (size_t)(u.pm * 256 + rl) * DM + u.pn * 256 + wc * 32 + 8 * fq;
#pragma unroll
                for (int bj = 0; bj < 2; ++bj) { const f32x4 a0 = acc[ai][bj][m][0] * r, a1 = acc[ai][bj][m][1] * r;
                    u32x4 w; w.x = cvt_pk_bf16(a0[0], a0[1]); w.y = cvt_pk_bf16(a0[2], a0[3]); w.z = cvt_pk_bf16(a1[0], a1[1]); w.w = cvt_pk_bf16(a1[2], a1[3]);
                    *GP(u32x4, p + bj * 128) = w; }
            }
    }
};
struct EpiGLU {
    const bf16_t* Y; bf16_t* MIX;
    __device__ __forceinline__ void operator()(const AccT& acc, const Unit& u, int ui, int wr, int wc, int fr, int fq) const {
#pragma unroll
        for (int ai = 0; ai < 2; ++ai) {
            u32x4 yv[4][2];
#pragma unroll
            for (int m = 0; m < 4; ++m)
#pragma unroll
                for (int bj = 0; bj < 2; ++bj) yv[m][bj] = *GP(const u32x4, Y + (size_t)(u.pm * 256 + ai * 128 + wr * 64 + m * 16 + fr) * 512 + u.pn * 256 + bj * 128 + wc * 32 + 8 * fq);
#pragma unroll
            for (int m = 0; m < 4; ++m) {
                const int row = u.pm * 256 + ai * 128 + wr * 64 + m * 16 + fr;
#pragma unroll
                for (int bj = 0; bj < 2; ++bj) {
                    const int col = u.pn * 256 + bj * 128 + wc * 32 + 8 * fq;
                    const u32x4 y = yv[m][bj];
                    const f32x4 a0 = acc[ai][bj][m][0], a1 = acc[ai][bj][m][1];
                    u32x4 w;
                    w.x = cvt_pk_bf16(bflo(y.x) * fsigmoid(a0[0]), bfhi(y.x) * fsigmoid(a0[1]));
                    w.y = cvt_pk_bf16(bflo(y.y) * fsigmoid(a0[2]), bfhi(y.y) * fsigmoid(a0[3]));
                    w.z = cvt_pk_bf16(bflo(y.z) * fsigmoid(a1[0]), bfhi(y.z) * fsigmoid(a1[1]));
                    w.w = cvt_pk_bf16(bflo(y.w) * fsigmoid(a1[2]), bfhi(y.w) * fsigmoid(a1[3]));
                    *GP(u32x4, MIX + (size_t)row * DM + col) = w;
                }
            }
            asm volatile("" ::: "memory");
        }
    }
};
struct EpiProj {
    bf16_t* O;
    __device__ __forceinline__ void operator()(const AccT& acc, const Unit& u, int ui, int wr, int wc, int fr, int fq) const {
#pragma unroll
        for (int ai = 0; ai < 2; ++ai)
#pragma unroll
            for (int m = 0; m < 4; ++m) {
#pragma unroll
                for (int bj = 0; bj < 2; ++bj) {
                    const f32x4 a0 = acc[ai][bj][m][0], a1 = acc[ai][bj][m][1];
                    u32x4 w; w.x = cvt_pk_bf16(a0[0], a0[1]); w.y = cvt_pk_bf16(a0[2], a0[3]); w.z = cvt_pk_bf16(a1[0], a1[1]); w.w = cvt_pk_bf16(a1[2], a1[3]);
                    *GP(u32x4, O + (tn_slot(u.pm, u.pn, wr * 4 + wc, ai, m, bj) * 64 + fq * 16 + fr) * 8) = w;
                }
            }
    }
};

__device__ __forceinline__ void build_rs(LAS float* rs, const float* ssp) {
    int tid = threadIdx.x, c = blockIdx.x; asm volatile("" : "+v"(tid), "+s"(c));
#pragma unroll
    for (int e2 = 0; e2 < 2; ++e2) {
        const int e = tid + e2 * NTHREADS, slot = e >> 8, t = e & 255;
        const int pm = 32 * (c & 7) + 8 * slot + ((c >> 3) & 7); const int row = pm * 256 + t; float sacc = 0.f;
#pragma unroll
        for (int q = 0; q < 16; ++q) sacc += *GP(const float, ssp + (size_t)q * TT + row);
        rs[slot * 256 + t] = 1.0f / sqrtf(sacc * (1.0f / 1024.0f) + 1e-6f);
    }
    __syncthreads();
}

__device__ __forceinline__ void convT_tile(const float* src, int ldsrc, const float* sc, bf16_t* dst, int dstld, int k0, int n0, int swiglu, LAS float* t) {
    const int tid = threadIdx.x;
    { const int r = tid >> 6, c4 = (tid & 63) * 4;
      int ncol = n0 + c4; if (swiglu) { const int blk = n0 >> 8; ncol = (c4 < 128) ? (128 * blk + c4) : (FF + 128 * blk + (c4 - 128)); }
      f32x4 v[8]; float sv[8];
#pragma unroll
      for (int i = 0; i < 8; ++i) { const int rr = r + 8 * i; v[i] = *(const f32x4*)(src + (size_t)(k0 + rr) * ldsrc + ncol); sv[i] = sc ? sc[k0 + rr] : 1.0f; }
#pragma unroll
      for (int i = 0; i < 8; ++i) { const int rr = r + 8 * i; t[rr * 257 + c4 + 0] = v[i][0] * sv[i]; t[rr * 257 + c4 + 1] = v[i][1] * sv[i]; t[rr * 257 + c4 + 2] = v[i][2] * sv[i]; t[rr * 257 + c4 + 3] = v[i][3] * sv[i]; } }
    __syncthreads();
    { const int nn = tid >> 1, kh = (tid & 1) * 32;
#pragma unroll
      for (int q = 0; q < 4; ++q) { float v[8];
#pragma unroll
          for (int j = 0; j < 8; ++j) v[j] = t[(kh + q * 8 + j) * 257 + nn];
          u32x4 w; w.x = cvt_pk_bf16(v[0], v[1]); w.y = cvt_pk_bf16(v[2], v[3]); w.z = cvt_pk_bf16(v[4], v[5]); w.w = cvt_pk_bf16(v[6], v[7]);
          *(u32x4*)(dst + (size_t)(n0 + nn) * dstld + k0 + kh + q * 8) = w; } }
    __syncthreads();
}
__device__ __forceinline__ void convT(const float* src, int ldsrc, const float* sc, bf16_t* dst, int dstld, int Krows, int Ncols, int swiglu, LAS float* t, int& base) {
    const int G = gridDim.x, nkt = Krows / 64, ntiles = nkt * (Ncols / 256);
    int first = ((int)blockIdx.x - (base % G) + G) % G;
    for (int idx = first; idx < ntiles; idx += G) {
        const int kt = idx % nkt, ntile = idx / nkt;
        convT_tile(src, ldsrc, sc, dst, dstld, kt * 64, ntile * 256, swiglu, t);
    }
    base += ntiles;
}
__device__ __forceinline__ void conv_poolout(const float* pw, const float* pscale, const float* wout, bf16_t* dst, LAS float* t, int& base) {
    const int G = gridDim.x, tid = threadIdx.x, ntiles = 8 * 16;
    int first = ((int)blockIdx.x - (base % G) + G) % G;
    for (int idx = first; idx < ntiles; idx += G) {
        const int k0 = (idx & 7) * 64, n0 = (idx >> 3) * 64;
        const int tn = tid & 63, tk = tid >> 6; const int kb = k0 + tk * 8; const int gi = kb >> 7, kk0 = kb & 127;
        float a[8];
#pragma unroll
        for (int i = 0; i < 8; ++i) a[i] = 0.f;
        const float* pwg = pw + (size_t)gi * 128 * 128 + (size_t)kk0 * 128;
        for (int m = 0; m < 128; ++m) {
            const float w = wout[(size_t)(512 + gi * 128 + m) * DM + n0 + tn] * pscale[gi * 128 + m];
#pragma unroll
            for (int i = 0; i < 8; ++i) a[i] += pwg[i * 128 + m] * w;
        }
#pragma unroll
        for (int i = 0; i < 8; ++i) t[(tk * 8 + i) * 65 + tn] = a[i];
        __syncthreads();
        { const int nn = tid >> 3, k8 = (tid & 7) * 8; float v[8];
#pragma unroll
          for (int j = 0; j < 8; ++j) v[j] = t[(k8 + j) * 65 + nn];
          u32x4 w; w.x = cvt_pk_bf16(v[0], v[1]); w.y = cvt_pk_bf16(v[2], v[3]); w.z = cvt_pk_bf16(v[4], v[5]); w.w = cvt_pk_bf16(v[6], v[7]);
          *(u32x4*)(dst + (size_t)(n0 + nn) * DM + 512 + k0 + k8) = w; }
        __syncthreads();
    }
    base += ntiles;
}

__device__ __forceinline__ void dsincos(double th, double& s, double& c) {
    const double k = rint(th * 0.63661977236758134308);
    const double r = (th - k * 1.57079632679489655800) - k * 6.123233995736766e-17;
    const double r2 = r * r;
    const double sp = r * (1.0 + r2 * (-1.0 / 6 + r2 * (1.0 / 120 + r2 * (-1.0 / 5040 + r2 * (1.0 / 362880 + r2 * (-1.0 / 39916800 + r2 * (1.0 / 6227020800.0)))))));
    const double cp = 1.0 + r2 * (-0.5 + r2 * (1.0 / 24 + r2 * (-1.0 / 720 + r2 * (1.0 / 40320 + r2 * (-1.0 / 3628800 + r2 * (1.0 / 479001600.0 + r2 * (-1.0 / 87178291200.0)))))));
    const int q = ((int)k) & 3;
    s = (q == 0) ? sp : (q == 1) ? cp : (q == 2) ? -sp : -cp;
    c = (q == 0) ? cp : (q == 1) ? -sp : (q == 2) ? -cp : sp;
}

__device__ void prologue(const Params& P, LAS unsigned char* lds) {
    int tid = threadIdx.x; asm volatile("" : "+v"(tid));
    const int lane = tid & 63, wave = tid >> 6, G = gridDim.x;
    unsigned char* ws = P.ws;
    {
        const float* x = P.in[0]; bf16_t* hb = (bf16_t*)(ws + WS_HB0); unsigned char* lo = ws + WS_LO; float* ssp = (float*)(ws + WS_SSP0);
        const int wid = __builtin_amdgcn_readfirstlane(wave), wr = wid >> 2, wc = wid & 3, fr = lane & 15, fq = lane >> 4;
        pg8::StaticOrder S; S.init(TT, DM, G, (int)blockIdx.x); Unit u;
        for (int i = 0; S.next(i, u); ++i)
#pragma unroll
            for (int ai = 0; ai < 2; ++ai)
#pragma unroll
                for (int m = 0; m < 4; ++m) {
                    const int rl = ai * 128 + wr * 64 + m * 16 + fr, row = u.pm * 256 + rl; float ss = 0.f;
#pragma unroll
                    for (int bj = 0; bj < 2; ++bj) {
                        const size_t off = (size_t)row * DM + u.pn * 256 + bj * 128 + wc * 32 + 8 * fq;
                        const f32x4 v0 = *(const f32x4*)(x + off), v1 = *(const f32x4*)(x + off + 4);
                        u32x4 w; w.x = cvt_pk_bf16(v0[0], v0[1]); w.y = cvt_pk_bf16(v0[2], v0[3]); w.z = cvt_pk_bf16(v1[0], v1[1]); w.w = cvt_pk_bf16(v1[2], v1[3]);
                        u32x2 wl; wl.x = lo_pack4(v0[0] - bflo(w.x), v0[1] - bfhi(w.x), v0[2] - bflo(w.y), v0[3] - bfhi(w.y)); wl.y = lo_pack4(v1[0] - bflo(w.z), v1[1] - bfhi(w.z), v1[2] - bflo(w.w), v1[3] - bfhi(w.w));
                        *(u32x4*)(hb + off) = w; *(u32x2*)(lo + (tn_slot(u.pm, u.pn, wid, ai, m, bj) * 64 + lane) * 8) = wl;
                        ss += (v0[0] * v0[0] + v0[1] * v0[1]) + (v0[2] * v0[2] + v0[3] * v0[3]) + (v1[0] * v1[0] + v1[1] * v1[1]) + (v1[2] * v1[2] + v1[3] * v1[3]);
                    }
                    ss += __shfl_xor(ss, 16); ss += __shfl_xor(ss, 32);
                    if (fq == 0) ssp[(size_t)(u.pn * 4 + wc) * TT + row] = ss;
                }
    }
    {
        LAS float* t = (LAS float*)lds; int base = 0;
        for (int l = 0; l < NLAYER; ++l) {
            bf16_t* W = (bf16_t*)(ws + WS_W) + (size_t)l * LW;
            convT(P.in[3] + (size_t)l * DM * 2 * FF, 2 * FF, P.in[2] + l * DM, W + W_WI1, DM, DM, 2 * FF, 1, t, base);
            convT(P.in[4] + (size_t)l * FF * DM, DM, nullptr, W + W_WO1, FF, FF, DM, 0, t, base);
            convT(P.in[6] + (size_t)l * DM * DM, DM, P.in[5] + l * DM, W + W_WIN, DM, DM, DM, 0, t, base);
            convT(P.in[15] + (size_t)l * 512 * 512, 512, nullptr, W + W_GLU, 512, 512, 512, 0, t, base);
            convT(P.in[18] + (size_t)l * DM * DM, DM, nullptr, W + W_OUT, DM, 512, DM, 0, t, base);
            conv_poolout(P.in[16] + (size_t)l * 4 * 128 * 128, P.in[17] + l * 512, P.in[18] + (size_t)l * DM * DM, W + W_OUT, t, base);
            convT(P.in[20] + (size_t)l * DM * 2 * FF, 2 * FF, P.in[19] + l * DM, W + W_WI2, DM, DM, 2 * FF, 1, t, base);
            convT(P.in[21] + (size_t)l * FF * DM, DM, nullptr, W + W_WO2, FF, FF, DM, 0, t, base);
            convT(P.in[23] + (size_t)l * DM * DM, DM, P.in[22] + l * DM, W + W_GATE, DM, DM, DM, 0, t, base);
            convT(P.in[24] + (size_t)l * 256 * DM, DM, nullptr, W + W_PLE, 256, 256, DM, 0, t, base);
        }
    }
    {
        const int gt = blockIdx.x * NTHREADS + tid, nthr = G * NTHREADS;
        for (int it = gt; it < NLAYER * 2048; it += nthr) {
            const int l = it >> 11, gp = it & 2047, g = gp >> 6;
            const double lr = P.in[7][it], li = P.in[8][it]; const double dt = (double)expf(P.in[9][l * 32 + g]);
            double sn, cs; dsincos(li * dt, sn, cs); const double mag = (double)expf((float)(lr * dt));
            const float ar = (float)(mag * cs), ai = (float)(mag * sn);
            unsigned char* sb = ws + WS_SSM + (size_t)l * SSM_LBYTES;
            ((float*)(sb + SSM_LAMB))[gp * 2] = ar; ((float*)(sb + SSM_LAMB))[gp * 2 + 1] = ai;
            double pr = ar, pi = ai;
#pragma unroll
            for (int s = 0; s < 10; ++s) { const double nr = pr * pr - pi * pi, ni = 2.0 * pr * pi; pr = nr; pi = ni; }
            ((float*)(sb + SSM_LAMB1K))[gp * 2] = (float)pr; ((float*)(sb + SSM_LAMB1K))[gp * 2 + 1] = (float)pi;
            const double nr = mag * cs - 1.0, ni = mag * sn, den = lr * lr + li * li;
            const double qr = (nr * lr + ni * li) / den, qi = (ni * lr - nr * li) / den;
            bf16_t* Bf = (bf16_t*)(sb + SSM_BFRAG) + (size_t)g * 8 * 64 * 4;
            const float* bre = P.in[10] + (size_t)it * 16; const float* bim = P.in[11] + (size_t)it * 16;
            const int p = gp & 63, tq = p >> 4, frr = p & 15;
#pragma unroll
            for (int hh = 0; hh < 16; ++hh) { const double br = bre[hh], bi = bim[hh]; const int ln = (hh >> 2) * 16 + frr, i = hh & 3;
                Bf[((size_t)tq * 64 + ln) * 4 + i] = f2bf((float)(qr * br - qi * bi)); Bf[((size_t)(tq + 4) * 64 + ln) * 4 + i] = f2bf((float)(qr * bi + qi * br)); }
        }
        for (int it = gt; it < NLAYER * 32 * 4 * 64 * 8; it += nthr) {
            const int i = it & 7, ln = (it >> 3) & 63, kt = (it >> 9) & 3, g = (it >> 11) & 31, l = it >> 16;
            const int hh = ln & 15, k = 32 * kt + 8 * (ln >> 4) + i, p = k >> 1;
            const size_t ci = (((size_t)l * 32 + g) * 16 + hh) * 64 + p;
            const float v = (k & 1) ? -P.in[13][ci] : P.in[12][ci];
            ((bf16_t*)(ws + WS_SSM + (size_t)l * SSM_LBYTES + SSM_CFRAG))[it & 65535] = f2bf(v);
        }
    }
}

__device__ __forceinline__ void conv_p(const Params& P, int l) {
    const float* src = P.in[1] + (size_t)l * TT * 256; bf16_t* dst = (bf16_t*)(P.ws + WS_PB);
    const size_t n8 = (size_t)TT * 256 / 8, stride = (size_t)gridDim.x * NTHREADS;
    size_t i = (size_t)blockIdx.x * NTHREADS + threadIdx.x;
    for (; i + 3 * stride < n8; i += 4 * stride) {
        f32x4 a[4], b[4];
#pragma unroll
        for (int q = 0; q < 4; ++q) { a[q] = *(const f32x4*)(src + (i + q * stride) * 8); b[q] = *(const f32x4*)(src + (i + q * stride) * 8 + 4); }
#pragma unroll
        for (int q = 0; q < 4; ++q) { u32x4 w; w.x = cvt_pk_bf16(a[q][0], a[q][1]); w.y = cvt_pk_bf16(a[q][2], a[q][3]); w.z = cvt_pk_bf16(b[q][0], b[q][1]); w.w = cvt_pk_bf16(b[q][2], b[q][3]);
            *(u32x4*)(dst + (i + q * stride) * 8) = w; }
    }
    for (; i < n8; i += stride) {
        const f32x4 a = *(const f32x4*)(src + i * 8), b = *(const f32x4*)(src + i * 8 + 4);
        u32x4 w; w.x = cvt_pk_bf16(a[0], a[1]); w.y = cvt_pk_bf16(a[2], a[3]); w.z = cvt_pk_bf16(b[0], b[1]); w.w = cvt_pk_bf16(b[2], b[3]);
        *(u32x4*)(dst + i * 8) = w;
    }
}

typedef short bf16x4 __attribute__((ext_vector_type(4)));
template <int PASS> __device__ void ssm_pass(const Params& P, int l, LAS unsigned char* lds) {
    int tid = threadIdx.x; asm volatile("" : "+v"(tid));
    const int lane = tid & 63, wave = __builtin_amdgcn_readfirstlane(tid >> 6), G = gridDim.x, fr = lane & 15, fq = lane >> 4;
    unsigned char* ws = P.ws;
    const bf16_t* z = (const bf16_t*)(ws + WS_BIG + BIG_Z); float* E = (float*)(ws + WS_BIG + BIG_E); bf16_t* ypre = (bf16_t*)(ws + WS_BIG + BIG_YPRE);
    const unsigned char* sb = ws + WS_SSM + (size_t)l * SSM_LBYTES;
    const float* lamb = (const float*)(sb + SSM_LAMB); const float* lamb1k = (const float*)(sb + SSM_LAMB1K);
    const bf16_t* Bfrag = (const bf16_t*)(sb + SSM_BFRAG); const bf16_t* Cfrag = (const bf16_t*)(sb + SSM_CFRAG); const float* dskip = P.in[14] + l * 512;
    LAS unsigned char* BU = lds + wave * 12800;
    LAS unsigned char* SI = BU + 8448;
    for (int unit = blockIdx.x; unit < 256; unit += G) {
        const int b = unit >> 4, r = (unit >> 2) & 3, g = (unit & 3) * 8 + wave;
        const size_t tok0 = (size_t)b * SEQ + r * 1024;
        const f32x2 a = *(const f32x2*)(lamb + (g * 64 + lane) * 2);
        bf16x4 bf[8];
#pragma unroll
        for (int t = 0; t < 8; ++t) bf[t] = *(const bf16x4*)(Bfrag + ((size_t)(g * 8 + t) * 64 + lane) * 4);
        float sr = 0.f, si = 0.f;
        bf16x8 cf[4]; f32x4 dd;
        if (PASS == 2) {
            const f32x2 a1k = *(const f32x2*)(lamb1k + (g * 64 + lane) * 2);
            for (int rr = 0; rr < r; ++rr) { const f32x2 e = *(const f32x2*)(E + ((size_t)((b * 32 + g) * 4 + rr) * 64 + lane) * 2);
                const float nr = a1k.x * sr - a1k.y * si + e.x, ni = a1k.x * si + a1k.y * sr + e.y; sr = nr; si = ni; }
#pragma unroll
            for (int kt = 0; kt < 4; ++kt) cf[kt] = *(const bf16x8*)(Cfrag + ((size_t)(g * 4 + kt) * 64 + lane) * 8);
            dd = *(const f32x4*)(dskip + g * 16 + 4 * fq);
        }
        f32x2 sv = {sr, si}; const f32x2 axx = {a.x, a.x}, ayn = {-a.y, a.y};
        const bf16_t* zrow = z + (tok0 + fr) * DM + g * 16 + 4 * fq;
        u32x2 ucur = *(const u32x2*)zrow;
#pragma nounroll
        for (int mt = 0; mt < 64; ++mt) {
            u32x2 unext = ucur; if (mt < 63) unext = *(const u32x2*)(zrow + (size_t)(mt + 1) * 16 * DM);
            const bf16x4 af = __builtin_bit_cast(bf16x4, ucur);
            f32x4 d[8];
#pragma unroll
            for (int t = 0; t < 8; ++t) d[t] = __builtin_amdgcn_mfma_f32_16x16x16bf16_1k(af, bf[t], (f32x4){0.f, 0.f, 0.f, 0.f}, 0, 0, 0);
#pragma unroll
            for (int tq = 0; tq < 4; ++tq)
#pragma unroll
                for (int j = 0; j < 4; ++j) *(LAS f32x2*)(BU + (4 * fq + j) * 528 + (16 * tq + fr) * 8) = (f32x2){d[tq][j], d[tq + 4][j]};
            asm volatile("s_waitcnt lgkmcnt(0)" ::: "memory");
#pragma unroll
            for (int j = 0; j < 16; ++j) {
                const f32x2 bu = *(const LAS f32x2*)(BU + j * 528 + lane * 8);
                sv = __builtin_elementwise_fma(ayn, __builtin_shufflevector(sv, sv, 1, 0), __builtin_elementwise_fma(axx, sv, bu));
                if (PASS == 2) *(LAS unsigned*)(SI + j * 272 + lane * 4) = cvt_pk_bf16(sv.x, sv.y);
            }
            if (PASS == 2) {
                asm volatile("s_waitcnt lgkmcnt(0)" ::: "memory");
                f32x4 acc = (f32x4){0.f, 0.f, 0.f, 0.f};
#pragma unroll
                for (int kt = 0; kt < 4; ++kt) { const bf16x8 sv = *(const LAS bf16x8*)(SI + fr * 272 + (32 * kt + 8 * fq) * 2);
                    acc = __builtin_amdgcn_mfma_f32_16x16x32_bf16(cf[kt], sv, acc, 0, 0, 0); }
                const size_t tok = tok0 + 16 * mt + fr;
                float o[4];
                const float uf[4] = {bflo(ucur.x), bfhi(ucur.x), bflo(ucur.y), bfhi(ucur.y)};
#pragma unroll
                for (int j = 0; j < 4; ++j) { const float y = acc[j] + dd[j] * uf[j]; o[j] = y * fsigmoid(1.5957691216057308f * (y + 0.044715f * y * y * y)); }
                u32x2 w; w.x = cvt_pk_bf16(o[0], o[1]); w.y = cvt_pk_bf16(o[2], o[3]);
                *(u32x2*)(ypre + tok * 512 + g * 16 + 4 * fq) = w;
            }
            asm volatile("" ::: "memory");
            ucur = unext;
        }
        if (PASS == 1) *(f32x2*)(E + ((size_t)((b * 32 + g) * 4 + r) * 64 + lane) * 2) = sv;
    }
}

__device__ __forceinline__ float bf2f(bf16_t v) { return __uint_as_float(((unsigned)v) << 16); }
template <int W> __device__ __forceinline__ void pool_round2(const bf16_t* zpa, bf16_t* mpa, const bf16_t* zpb, bf16_t* mpb, int t0) {
    float a[W - 1 + 16], c[W - 1 + 16];
#pragma unroll
    for (int i = 0; i < W - 1 + 16; ++i) { const int t = t0 - (W - 1) + i; a[i] = (t >= 0) ? bf2f(zpa[(size_t)t * DM]) : 0.f; c[i] = (t >= 0) ? bf2f(zpb[(size_t)t * DM]) : 0.f; }
    float sa = 0.f, sc = 0.f;
#pragma unroll
    for (int i = 0; i < W - 1; ++i) { sa += a[i]; sc += c[i]; }
#pragma unroll
    for (int j = 0; j < 16; ++j) {
        const int t = t0 + j; const float va = a[W - 1 + j], vc = c[W - 1 + j]; sa += va; sc += vc;
        const float inv = 1.0f / (float)((t + 1 < W) ? t + 1 : W);
        mpa[(size_t)t * DM] = f2bf(sa * inv - va); mpb[(size_t)t * DM] = f2bf(sc * inv - vc);
        sa -= a[j]; sc -= c[j];
    }
}
__device__ void pool_phase(const Params& P) {
    int tid = threadIdx.x; asm volatile("" : "+v"(tid));
    const int G = gridDim.x; unsigned char* ws = P.ws;
    const bf16_t* z = (const bf16_t*)(ws + WS_BIG + BIG_Z); bf16_t* mix = (bf16_t*)(ws + WS_BIG + BIG_MIX);
    const int ch = tid, gi = __builtin_amdgcn_readfirstlane(ch >> 7);
    for (int q = blockIdx.x; q < 2048; q += G) {
        const int t0 = (q & 255) * 16, b0 = (q >> 8) * 2;
        const bf16_t* zpa = z + (size_t)b0 * SEQ * DM + 512 + ch; bf16_t* mpa = mix + (size_t)b0 * SEQ * DM + 512 + ch;
        const bf16_t* zpb = zpa + (size_t)SEQ * DM; bf16_t* mpb = mpa + (size_t)SEQ * DM;
        if (gi == 0) pool_round2<2>(zpa, mpa, zpb, mpb, t0); else if (gi == 1) pool_round2<4>(zpa, mpa, zpb, mpb, t0); else if (gi == 2) pool_round2<8>(zpa, mpa, zpb, mpb, t0); else pool_round2<16>(zpa, mpa, zpb, mpb, t0);
    }
}

__device__ void final_norm(const Params& P, const LAS float* rs, const bf16_t* hi, const unsigned char* lo) {
    int tid = threadIdx.x; asm volatile("" : "+v"(tid));
    const int lane = tid & 63, wid = __builtin_amdgcn_readfirstlane(tid >> 6), wr = wid >> 2, wc = wid & 3, fr = lane & 15, fq = lane >> 4;
    float* out = P.out; const float* fn = P.in[25];
    pg8::StaticOrder S; S.init(TT, DM, (int)gridDim.x, (int)blockIdx.x); Unit u;
    for (int i = 0; S.next(i, u); ++i) {
        f32x4 w[2][2];
#pragma unroll
        for (int bj = 0; bj < 2; ++bj) { w[bj][0] = *(const f32x4*)(fn + u.pn * 256 + bj * 128 + wc * 32 + 8 * fq); w[bj][1] = *(const f32x4*)(fn + u.pn * 256 + bj * 128 + wc * 32 + 8 * fq + 4); }
#pragma unroll
        for (int ai = 0; ai < 2; ++ai)
#pragma unroll
            for (int m = 0; m < 4; ++m) {
                const int rl = ai * 128 + wr * 64 + m * 16 + fr, row = u.pm * 256 + rl; const float r = rs[((u.pm >> 3) & 3) * 256 + rl];
#pragma unroll
                for (int bj = 0; bj < 2; ++bj) {
                    const size_t off = (size_t)row * DM + u.pn * 256 + bj * 128 + wc * 32 + 8 * fq;
                    const u32x4 H = *(const u32x4*)(hi + off); const u32x2 L = *(const u32x2*)(lo + (tn_slot(u.pm, u.pn, wid, ai, m, bj) * 64 + lane) * 8);
                    const f32x4 o0 = ((f32x4){bflo(H.x), bfhi(H.x), bflo(H.y), bfhi(H.y)} + lo_unpack4(L.x)) * r * w[bj][0];
                    const f32x4 o1 = ((f32x4){bflo(H.z), bfhi(H.z), bflo(H.w), bfhi(H.w)} + lo_unpack4(L.y)) * r * w[bj][1];
                    *(f32x4*)(out + off) = o0; *(f32x4*)(out + off + 4) = o1;
                }
            }
    }
}

__global__ void __launch_bounds__(NTHREADS, 2) mega_fwd(Params P) {
    extern __shared__ __attribute__((aligned(16))) unsigned char lds_raw[];
    LAS unsigned char* lds = (LAS unsigned char*)lds_raw;
    LAS float* rs = (LAS float*)(lds + STAGE_LDS);
    cg::grid_group grid = cg::this_grid();
#ifndef PHMASK
#define PHMASK 0xFFFF
#endif
#define HBC(l) ((bf16_t*)(wsb + (((l) & 1) ? WS_HB1 : WS_HB0)))
#define HBN(l) ((bf16_t*)(wsb + (((l) & 1) ? WS_HB0 : WS_HB1)))
#define SSPC(l) ((float*)(wsb + (((l) & 1) ? WS_SSP1 : WS_SSP0)))
#define SSPN(l) ((float*)(wsb + (((l) & 1) ? WS_SSP0 : WS_SSP1)))
#define WL(l) ((const bf16_t*)(wsb + WS_W) + (size_t)(l) * LW)
#define BIGP(T_, off) ((T_*)(wsb + WS_BIG + (off)))
#define LOP ((unsigned char*)(wsb + WS_LO))
    volatile LAS unsigned* xbst = (volatile LAS unsigned*)(lds + LDS_BYTES - 16);
    if (threadIdx.x < 4) xbst[threadIdx.x] = 0u;
    __syncthreads();
    const XcdBarrier xbar = xcd_barrier_post((unsigned*)(P.ws + WS_BAR), xbst);
    if (PHMASK & 1) prologue(P, lds);
    grid.sync();

    for (int ph = 0; ph < NLAYER * 11; ++ph) {
        const int l = ph / 11, k = ph - l * 11;
#ifndef REPK
#define REPK -1
#define REPN 1
#endif
        for (int rep = 0; rep < ((k == REPK) ? REPN : 1); ++rep) {
        int G = gridDim.x, cid = blockIdx.x; unsigned char* wsb = P.ws; asm volatile("" : "+s"(G), "+s"(cid), "+s"(wsb));
        switch (k) {
        case 0: if (PHMASK & 2) {
            pg8::RevOrder S; S.init(TT, 2 * FF, G, cid); build_rs(rs, SSPC(l));
            pg8::Gemm g{HBC(l), WL(l) + W_WI1, TT, 2 * FF, DM}; EpiSwiGLU E{BIGP(bf16_t, BIG_HID), rs}; pg8::gemm_phase(lds, g, S, E); } break;
        case 1: if (PHMASK & 4) {
            pg8::StaticOrder S; S.init(TT, DM, G, cid);
            pg8::Gemm g{BIGP(bf16_t, BIG_HID), WL(l) + W_WO1, TT, DM, FF}; EpiH<0> E{HBC(l), HBC(l), LOP, SSPC(l), 0.5f, nullptr, rs}; pg8::gemm_phase(lds, g, S, E); } break;
        case 2: if (PHMASK & 8) {
            pg8::RevOrder S; S.init(TT, DM, G, cid); build_rs(rs, SSPC(l));
            pg8::Gemm g{HBC(l), WL(l) + W_WIN, TT, DM, DM}; EpiZ E{BIGP(bf16_t, BIG_Z), rs}; pg8::gemm_phase(lds, g, S, E); } break;
        case 3: if (PHMASK & 16) {
            ssm_pass<1>(P, l, lds); pool_phase(P); conv_p(P, l); } break;
        case 4: if (PHMASK & 32) {
            ssm_pass<2>(P, l, lds); } break;
        case 5: if (PHMASK & 64) {
            pg8::StaticOrder S; S.init(TT, 512, G, cid);
            pg8::Gemm g{BIGP(bf16_t, BIG_YPRE), WL(l) + W_GLU, TT, 512, 512}; EpiGLU E{BIGP(bf16_t, BIG_YPRE), BIGP(bf16_t, BIG_MIX)}; pg8::gemm_phase(lds, g, S, E); } break;
        case 6: if (PHMASK & 128) {
            pg8::RevOrder S; S.init(TT, DM, G, cid);
            pg8::Gemm g{BIGP(bf16_t, BIG_MIX), WL(l) + W_OUT, TT, DM, DM}; EpiH<0> E{HBC(l), HBC(l), LOP, SSPC(l), 1.0f, nullptr, rs}; pg8::gemm_phase(lds, g, S, E); } break;
        case 7: if (PHMASK & 256) {
            pg8::StaticOrder S; S.init(TT, 2 * FF, G, cid); build_rs(rs, SSPC(l));
            pg8::Gemm g{HBC(l), WL(l) + W_WI2, TT, 2 * FF, DM}; EpiSwiGLU E{BIGP(bf16_t, BIG_HID), rs}; pg8::gemm_phase(lds, g, S, E); } break;
        case 8: if (PHMASK & 512) {
            pg8::RevOrder S; S.init(TT, DM, G, cid);
            pg8::Gemm g{BIGP(bf16_t, BIG_HID), WL(l) + W_WO2, TT, DM, FF}; EpiH<0> E{HBC(l), HBC(l), LOP, SSPC(l), 0.5f, nullptr, rs}; pg8::gemm_phase(lds, g, S, E); } break;
        case 9: if (PHMASK & 1024) {
            pg8::StaticOrder S; S.init(TT, DM, G, cid); build_rs(rs, SSPC(l));
            pg8::Gemm g{(const bf16_t*)(wsb + WS_PB), WL(l) + W_PLE, TT, DM, 256}; EpiProj E{BIGP(bf16_t, BIG_PROJ)}; pg8::gemm_phase(lds, g, S, E); } break;
        default: if (PHMASK & 1024) {
            pg8::StaticOrder S; S.init(TT, DM, G, cid);
            pg8::Gemm g{HBC(l), WL(l) + W_GATE, TT, DM, DM}; EpiH<1> E{HBC(l), HBN(l), LOP, SSPN(l), 1.0f, BIGP(bf16_t, BIG_PROJ), rs}; pg8::gemm_phase(lds, g, S, E); } break;
        }
        if (k != 9) xcd_barrier(xbar);
        }
    }
    if (PHMASK & 0x800) { build_rs(rs, (const float*)(P.ws + ((NLAYER & 1) ? WS_SSP1 : WS_SSP0))); final_norm(P, rs, (const bf16_t*)(P.ws + ((NLAYER & 1) ? WS_HB1 : WS_HB0)), (const unsigned char*)(P.ws + WS_LO)); }
}

extern "C" void kernel_launch(void* const* d_in, const int* in_sizes, int n_in, void* d_out, int out_size, void* d_ws, size_t ws_size, hipStream_t stream) {
    static int grid_blocks = 0;
    if (!grid_blocks) {
        int dev = 0, cus = 0, per_cu = 0;
        hipGetDevice(&dev);
        hipDeviceGetAttribute(&cus, hipDeviceAttributeMultiprocessorCount, dev);
        if (hipFuncSetAttribute((const void*)mega_fwd, hipFuncAttributeMaxDynamicSharedMemorySize, LDS_BYTES) != hipSuccess) fprintf(stderr, "hipFuncSetAttribute failed\n");
        if (hipOccupancyMaxActiveBlocksPerMultiprocessor(&per_cu, (const void*)mega_fwd, NTHREADS, LDS_BYTES) != hipSuccess || per_cu < 1) { per_cu = 1; (void)hipGetLastError(); }
        grid_blocks = cus * 1;
        if (ws_size < WS_END) fprintf(stderr, "workspace too small: %zu < %zu\n", ws_size, (size_t)WS_END);
    }
    Params p{};
    for (int i = 0; i < 26; ++i) p.in[i] = (const float*)d_in[i];
    p.out = (float*)d_out; p.ws = (unsigned char*)d_ws;
    if (hipMemsetAsync((char*)d_ws + WS_BAR, 0, 16384, stream) != hipSuccess) fprintf(stderr, "memset of barrier words failed\n");
    void* args[] = {&p};
    hipError_t e = hipLaunchCooperativeKernel((void*)mega_fwd, dim3(grid_blocks), dim3(NTHREADS), args, LDS_BYTES, stream);
    if (e != hipSuccess) fprintf(stderr, "cooperative launch failed: %s (grid %d)\n", hipGetErrorString(e), grid_blocks);
}
```
